# Optimizing an MI355X kernel written in HIP

```python
import jax
import jax.numpy as jnp
from jax import lax
import numpy as np

D_MODEL = 1024
BATCH = 2
SEQ = 8192
DEPTH = 2

CHUNK = 64
N_AB = (DEPTH + 1) // 2
N_C = DEPTH // 2
RMS_EPS = 1e-6
RG_WIDTH = D_MODEL
RG_BLOCKS = 16
RG_BLOCK = RG_WIDTH // RG_BLOCKS
RG_CONV = 4
RG_C = 8.0
HG_HEADS = 8
HG_DK = D_MODEL // HG_HEADS
HG_DV = D_MODEL // HG_HEADS
HG_KW = HG_HEADS * HG_DK
HG_VW = HG_HEADS * HG_DV
AB_SPLITS = (RG_WIDTH, RG_WIDTH, HG_KW, HG_KW, HG_VW, HG_VW)
AB_IN = sum(AB_SPLITS)
AB_OUT = RG_WIDTH + HG_VW
RW_HEAD = 64
RW_HEADS = D_MODEL // RW_HEAD
RW_WIDTH = RW_HEADS * RW_HEAD
RW_DECAY_LORA = 64
RW_AAA_LORA = 64
RW_GN_EPS = 64e-5

kernel_name = "hybrid_rglru_hgrn2_rwkv7_trunk"


def _f32(t):
    return t.astype(jnp.float32)


def rms_norm(x, gain):
    xf = _f32(x)
    return xf * lax.rsqrt(jnp.mean(xf * xf, axis=-1, keepdims=True) + RMS_EPS) * _f32(gain)


def _linear_scan_combine(left, right):
    a_l, b_l = left
    a_r, b_r = right
    return a_l * a_r, a_r * b_l + b_r


def rglru_mixer(xb, conv_w, conv_b, w_a, b_a, w_x, b_x, lam):
    bsz, seq, _ = xb.shape
    xc = lax.conv_general_dilated(xb, conv_w[:, None, :], window_strides=(1,),
                                  padding=[(RG_CONV - 1, 0)],
                                  dimension_numbers=("NWC", "WIO", "NWC"),
                                  feature_group_count=RG_WIDTH) + conv_b
    xblk = xc.reshape(bsz, seq, RG_BLOCKS, RG_BLOCK)
    gate_r = jax.nn.sigmoid(jnp.einsum("bsni,nij->bsnj", xblk, w_a).reshape(bsz, seq, RG_WIDTH) + b_a)
    gate_i = jax.nn.sigmoid(jnp.einsum("bsni,nij->bsnj", xblk, w_x).reshape(bsz, seq, RG_WIDTH) + b_x)
    log_a = -RG_C * gate_r * jax.nn.softplus(-lam)
    a = jnp.exp(log_a)
    b = jnp.sqrt(-jnp.expm1(2.0 * log_a)) * (gate_i * xc)
    _, h = lax.associative_scan(_linear_scan_combine, (a, b), axis=1)
    return h


def hgrn2_mixer(q, f_raw, v, lb):
    bsz, seq, _ = q.shape
    n_chunks = seq // CHUNK
    q = jax.nn.silu(q)
    log_f = jnp.logaddexp(jnp.log(lb), jnp.log1p(-lb) + jax.nn.log_sigmoid(f_raw))
    k = -jnp.expm1(log_f)

    def to_chunks(t, d):
        return t.reshape(bsz, n_chunks, CHUNK, HG_HEADS, d).transpose(1, 0, 3, 2, 4)

    qc = to_chunks(q, HG_DK)
    kc = to_chunks(k, HG_DK)
    vc = to_chunks(v, HG_DV)
    gc = jnp.cumsum(to_chunks(log_f, HG_DK), axis=3)
    causal = jnp.tril(jnp.ones((CHUNK, CHUNK), dtype=bool))[None, None, :, :, None]

    def chunk_step(state, inp):
        q_c, k_c, v_c, g_c = inp
        rel = jnp.where(causal, g_c[:, :, :, None, :] - g_c[:, :, None, :, :], -jnp.inf)
        scores = jnp.einsum("bhtd,bhsd,bhtsd->bhts", q_c, k_c, jnp.exp(rel))
        out = (jnp.einsum("bhts,bhsv->bhtv", scores, v_c)
               + jnp.einsum("bhtd,bhdv->bhtv", q_c * jnp.exp(g_c), state))
        g_end = g_c[:, :, -1, :]
        new_state = (state * jnp.exp(g_end)[..., None]
                     + jnp.einsum("bhsd,bhsv->bhdv", k_c * jnp.exp(g_end[:, :, None, :] - g_c), v_c))
        return new_state, out

    state0 = jnp.zeros((bsz, HG_HEADS, HG_DK, HG_DV), jnp.float32)
    _, oc = lax.scan(chunk_step, state0, (qc, kc, vc, gc))
    return oc.transpose(1, 0, 3, 2, 4).reshape(bsz, seq, HG_HEADS, HG_DV)


def rglru_hgrn2_layer(u, w_in, w_out, conv_w, conv_b, w_a, b_a, w_x, b_x, lam, lb, g_norm):
    bsz, seq, _ = u.shape
    w_in, w_out, conv_w, conv_b, w_a, b_a, w_x, b_x, lam, g_norm = map(
        _f32, (w_in, w_out, conv_w, conv_b, w_a, b_a, w_x, b_x, lam, g_norm))
    proj = jnp.einsum("bsd,de->bse", u, w_in)
    rg_x, rg_g, hg_q, hg_f, hg_i, hg_g = jnp.split(proj, np.cumsum(AB_SPLITS)[:-1].tolist(), axis=-1)
    h = rglru_mixer(rg_x, conv_w, conv_b, w_a, b_a, w_x, b_x, lam)
    o = hgrn2_mixer(hg_q, hg_f, hg_i, lb)
    o = o * lax.rsqrt(jnp.mean(o * o, axis=-1, keepdims=True) + RMS_EPS) * g_norm
    merged = jnp.concatenate([h * jax.nn.silu(rg_g),
                              o.reshape(bsz, seq, HG_VW) * jax.nn.silu(hg_g)], axis=-1)
    return merged @ w_out


def rwkv7_layer(u, mu, w_in, w_out, w0, w1, w2, a0, a1, a2, k_k, k_a, r_k, ln_w, ln_b):
    bsz, seq, _ = u.shape
    mu, w_in, w_out, w0, w1, w2, a0, a1, a2, k_k, k_a, r_k, ln_w, ln_b = map(
        _f32, (mu, w_in, w_out, w0, w1, w2, a0, a1, a2, k_k, k_a, r_k, ln_w, ln_b))
    shifted = jnp.pad(u, ((0, 0), (1, 0), (0, 0)))[:, :-1]
    mixes = u[None] + (shifted - u)[None] * mu[:, None, None, :]
    r, k, v, g = jnp.einsum("pbsd,pdw->pbsw", mixes[:4], w_in)
    w_log = -jax.nn.softplus(-(w0 + jnp.tanh(mixes[4] @ w1) @ w2)) - 0.5
    decay = jnp.exp(-jnp.exp(w_log))
    iclr = jax.nn.sigmoid(a0 + (mixes[5] @ a1) @ a2)

    def heads(t):
        return t.reshape(bsz, seq, RW_HEADS, RW_HEAD)

    kk = heads(k * k_k)
    kk = kk / jnp.maximum(jnp.linalg.norm(kk, axis=-1, keepdims=True), 1e-12)
    k = heads(k * (1.0 + (iclr - 1.0) * k_a))
    r, v, decay, iclr = heads(r), heads(v), heads(decay), heads(iclr)

    def step(state, inp):
        r_t, w_t, k_t, v_t, al_t, be_t = inp
        sa = jnp.einsum("bhvk,bhk->bhv", state, al_t)
        state = (state * w_t[:, :, None, :] + sa[..., None] * be_t[:, :, None, :]
                 + v_t[..., None] * k_t[:, :, None, :])
        return state, jnp.einsum("bhvk,bhk->bhv", state, r_t)

    def time_major(t):
        return t.transpose(1, 0, 2, 3)

    state0 = jnp.zeros((bsz, RW_HEADS, RW_HEAD, RW_HEAD), jnp.float32)
    xs = (time_major(r), time_major(decay), time_major(k), time_major(v),
          time_major(-kk), time_major(kk * iclr))
    _, y = lax.scan(step, state0, xs)
    y = time_major(y)
    mean = jnp.mean(y, axis=-1, keepdims=True)
    var = jnp.mean(jnp.square(y - mean), axis=-1, keepdims=True)
    y = ((y - mean) * lax.rsqrt(var + RW_GN_EPS)).reshape(bsz, seq, RW_WIDTH) * ln_w + ln_b
    bonus = jnp.sum(r * k * r_k, axis=-1, keepdims=True) * v
    y = y + bonus.reshape(bsz, seq, RW_WIDTH)
    return (y * jax.nn.silu(g)) @ w_out


def setup_inputs(seed: int = 0) -> dict:
    key = jax.random.key(seed)
    ks = iter(jax.random.split(key, 40))

    def nrm(shape, scale):
        return scale * jax.random.normal(next(ks), shape, jnp.float32)

    def unif(shape, lo, hi):
        return jax.random.uniform(next(ks), shape, jnp.float32, lo, hi)

    x = nrm((BATCH, SEQ, D_MODEL), 1.0)
    pre_norm = 1.0 + nrm((DEPTH, D_MODEL), 0.02)
    post_norm = 1.0 + nrm((DEPTH, D_MODEL), 0.02)
    ab_w_in = nrm((N_AB, D_MODEL, AB_IN), D_MODEL ** -0.5)
    ab_w_out = nrm((N_AB, AB_OUT, D_MODEL), AB_OUT ** -0.5)
    rg_conv_w = nrm((N_AB, RG_CONV, RG_WIDTH), RG_CONV ** -0.5)
    rg_conv_b = nrm((N_AB, RG_WIDTH), 0.01)
    rg_w_a = nrm((N_AB, RG_BLOCKS, RG_BLOCK, RG_BLOCK), RG_BLOCK ** -0.5)
    rg_b_a = nrm((N_AB, RG_WIDTH), 0.01)
    rg_w_x = nrm((N_AB, RG_BLOCKS, RG_BLOCK, RG_BLOCK), RG_BLOCK ** -0.5)
    rg_b_x = nrm((N_AB, RG_WIDTH), 0.01)
    a_pow_c = unif((N_AB, RG_WIDTH), 0.9, 0.999)
    a_base = a_pow_c ** (1.0 / RG_C)
    rg_lambda = jnp.log(a_base) - jnp.log1p(-a_base)
    hg_lower_bounds = nrm((DEPTH + 1, HG_KW), 0.1)
    hg_out_norm = 1.0 + nrm((N_AB, HG_DV), 0.02)
    rw_mu = unif((N_C, 6, D_MODEL), 0.0, 1.0)
    rw_w_in = nrm((N_C, 4, D_MODEL, RW_WIDTH), D_MODEL ** -0.5)
    rw_w_out = nrm((N_C, RW_WIDTH, D_MODEL), RW_WIDTH ** -0.5)
    rw_w0 = unif((N_C, RW_WIDTH), -6.0, -1.0)
    rw_w1 = nrm((N_C, D_MODEL, RW_DECAY_LORA), D_MODEL ** -0.5)
    rw_w2 = nrm((N_C, RW_DECAY_LORA, RW_WIDTH), 0.1 * RW_DECAY_LORA ** -0.5)
    rw_a0 = nrm((N_C, RW_WIDTH), 0.1)
    rw_a1 = nrm((N_C, D_MODEL, RW_AAA_LORA), D_MODEL ** -0.5)
    rw_a2 = nrm((N_C, RW_AAA_LORA, RW_WIDTH), 0.1 * RW_AAA_LORA ** -0.5)
    rw_k_k = 0.85 + nrm((N_C, RW_WIDTH), 0.02)
    rw_k_a = 1.0 + nrm((N_C, RW_WIDTH), 0.02)
    rw_r_k = nrm((N_C, RW_HEADS, RW_HEAD), 0.1)
    rw_ln_w = 1.0 + nrm((N_C, RW_WIDTH), 0.02)
    rw_ln_b = nrm((N_C, RW_WIDTH), 0.01)
    return {"x": x, "pre_norm": pre_norm, "post_norm": post_norm,
            "ab_w_in": ab_w_in, "ab_w_out": ab_w_out,
            "rg_conv_w": rg_conv_w, "rg_conv_b": rg_conv_b,
            "rg_w_a": rg_w_a, "rg_b_a": rg_b_a, "rg_w_x": rg_w_x, "rg_b_x": rg_b_x,
            "rg_lambda": rg_lambda, "hg_lower_bounds": hg_lower_bounds, "hg_out_norm": hg_out_norm,
            "rw_mu": rw_mu, "rw_w_in": rw_w_in, "rw_w_out": rw_w_out,
            "rw_w0": rw_w0, "rw_w1": rw_w1, "rw_w2": rw_w2,
            "rw_a0": rw_a0, "rw_a1": rw_a1, "rw_a2": rw_a2,
            "rw_k_k": rw_k_k, "rw_k_a": rw_k_a, "rw_r_k": rw_r_k,
            "rw_ln_w": rw_ln_w, "rw_ln_b": rw_ln_b}


def reference(x, pre_norm, post_norm, ab_w_in, ab_w_out, rg_conv_w, rg_conv_b, rg_w_a, rg_b_a,
              rg_w_x, rg_b_x, rg_lambda, hg_lower_bounds, hg_out_norm, rw_mu, rw_w_in, rw_w_out,
              rw_w0, rw_w1, rw_w2, rw_a0, rw_a1, rw_a2, rw_k_k, rw_k_a, rw_r_k, rw_ln_w, rw_ln_b):
    lb_table = jnp.cumsum(jax.nn.softmax(_f32(hg_lower_bounds), axis=0), axis=0)
    for layer in range(DEPTH):
        j = layer // 2
        u = rms_norm(x, pre_norm[layer])
        if layer % 2 == 0:
            mix = rglru_hgrn2_layer(u, ab_w_in[j], ab_w_out[j], rg_conv_w[j], rg_conv_b[j],
                                    rg_w_a[j], rg_b_a[j], rg_w_x[j], rg_b_x[j], rg_lambda[j],
                                    lb_table[layer + 1] - lb_table[0], hg_out_norm[j])
        else:
            mix = rwkv7_layer(u, rw_mu[j], rw_w_in[j], rw_w_out[j], rw_w0[j], rw_w1[j], rw_w2[j],
                              rw_a0[j], rw_a1[j], rw_a2[j], rw_k_k[j], rw_k_a[j], rw_r_k[j],
                              rw_ln_w[j], rw_ln_b[j])
        x = x + rms_norm(mix, post_norm[layer]).astype(x.dtype)
    return x
```

```cpp
#include <hip/hip_runtime.h>
#include <cstdio>
#include <cstdint>
#include <cmath>
#ifndef MK_ONE_LAUNCH
#define MK_ONE_LAUNCH 1
#endif
namespace pg8 {
#define PG8_LAS __attribute__((address_space(3)))
typedef unsigned short bf16_t;
typedef short bf16x8 __attribute__((ext_vector_type(8)));
typedef float f32x4 __attribute__((ext_vector_type(4)));
typedef unsigned u32x4 __attribute__((ext_vector_type(4)));
constexpr int BM = 256, BK = 64, HALF = 128, HTB = HALF * BK * 2  , STAGE_BYTES = 8 * HTB, NXCD = 8, WGM = 8;

__host__ __device__ __forceinline__ int lds_byte(int r, int c) { const int st = (r >> 4) * 2 + (c >> 5), rr = r & 15, cc = c & 31, ob = rr * 64 + cc * 2; return st * 1024 + (ob ^ (((ob >> 9) & 1) << 5)); }
__host__ __device__ __forceinline__ void stage_rc(int b, int& R, int& C) { const int st = b / 1024, sb = b % 1024, swz = sb ^ (((sb >> 9) & 1) << 5); R = (st >> 1) * 16 + swz / 64; C = (st & 1) * 32 + (swz % 64) / 2; }
__host__ __device__ __forceinline__ int perm32(int rho) { const int n = rho >> 4, i = rho & 15; return 8 * (i >> 2) + 4 * n + (i & 3); }

struct Unit { int pm, pn; };
struct Gemm { const bf16_t* A; const bf16_t* Bt; int M, N, K, lda; };

struct StaticOrder {
    int nM, nN, nwg, G, c;
    __host__ __device__ void init(int M, int N, int G_, int c_) { nM = M / BM; nN = N / BM; nwg = nM * nN; G = G_; c = c_; }
    __host__ __device__ bool next(int i, Unit& u) const {
        const long L = (long)i * G + c; if (L >= nwg) return false;
        int wgid = (int)L; { const int q = nwg / NXCD, r = nwg % NXCD, xcd = wgid % NXCD, off = wgid / NXCD; wgid = (xcd < r ? xcd * (q + 1) : r * (q + 1) + (xcd - r) * q) + off; }
        const int nig = WGM * nN, gid = wgid / nig, fm = gid * WGM, gsz = (nM - fm) < WGM ? (nM - fm) : WGM;
        u.pm = fm + ((wgid % nig) % gsz); u.pn = (wgid % nig) / gsz; return true;
    }
    __device__ __forceinline__ void a_ready(const Unit&) const {}
    __device__ __forceinline__ void done(const Unit&) const {}
};

__device__ __forceinline__ unsigned cvt_pk_bf16(float lo, float hi) { unsigned r; asm volatile("v_cvt_pk_bf16_f32 %0, %1, %2" : "=v"(r) : "v"(lo), "v"(hi)); return r; }
typedef float f32x2 __attribute__((ext_vector_type(2)));
template <class Epi, class Sched, bool ALIGN_EPI = false, bool SP2 = false>
__device__ __forceinline__ void gemm_phase(PG8_LAS unsigned char* lds, const Gemm g, const Sched& S, const Epi& E) {
    const int tid = threadIdx.x, wid = __builtin_amdgcn_readfirstlane(tid >> 6), lane = tid & 63, wr = wid >> 2, wc = wid & 3, fr = lane & 15, fq = lane >> 4;
    const int K = g.K, nt = K / BK;
    unsigned voffA[2], voffB[2];
#pragma unroll
    for (int i = 0; i < 2; ++i) { int R, C; stage_rc(tid * 16 + i * 8192, R, C); const int Rb = Epi::PERM ? ((R & ~31) + perm32(R & 31)) : R;
        voffA[i] = (unsigned)(R * g.lda + C) * 2u; voffB[i] = (unsigned)(Rb * K + C) * 2u; }
    const size_t kstep = (size_t)(BK * 2);
    const size_t hstepA = (size_t)HALF * g.lda * 2, hstepB = (size_t)HALF * K * 2;
    const size_t tstepA = 2 * hstepA, tstepB = 2 * hstepB;
    const unsigned ldsw = (unsigned)wid * 1024u;
    const int aoff = lds_byte(wr * 64 + fr, fq * 8), boff = lds_byte(wc * 32 + fr, fq * 8);
#define PG8_SA(b, h) (((b) * 2 + (h)) * HTB)
#define PG8_SB(b, h) ((4 + (b) * 2 + (h)) * HTB)
#define PG8_STAGE(bufoff, gbase, voff) do { _Pragma("unroll") for (int _i = 0; _i < 2; ++_i) \
        __builtin_amdgcn_global_load_lds((const unsigned*)((const char*)(gbase) + (voff)[_i]), (PG8_LAS unsigned*)(lds + (bufoff) + ldsw + _i * 8192), 16, 0, 0); } while (0)
#define PG8_LDA(dst, b, h) do { _Pragma("unroll") for (int m = 0; m < 4; ++m) _Pragma("unroll") for (int k = 0; k < 2; ++k) dst[m][k] = *(const PG8_LAS bf16x8*)(lds + PG8_SA(b, h) + aoff + m * 2048 + k * 1024); } while (0)
#define PG8_LDB(dst, b, h) do { _Pragma("unroll") for (int n = 0; n < 2; ++n) _Pragma("unroll") for (int k = 0; k < 2; ++k) dst[n][k] = *(const PG8_LAS bf16x8*)(lds + PG8_SB(b, h) + boff + n * 2048 + k * 1024); } while (0)
#define PG8_MMA(ai, bj, At, Bt) do { __builtin_amdgcn_s_setprio(1); _Pragma("unroll") for (int m = 0; m < 4; ++m) _Pragma("unroll") for (int n = 0; n < 2; ++n) _Pragma("unroll") for (int k = 0; k < 2; ++k) \
        acc[ai][bj][m][n] = __builtin_amdgcn_mfma_f32_16x16x32_bf16(Bt[n][k], At[m][k], acc[ai][bj][m][n], 0, 0, 0); __builtin_amdgcn_s_setprio(0); } while (0)
#define PG8_WAIT_V(n) asm volatile("s_waitcnt vmcnt(" #n ")" ::: "memory")
#define PG8_WAIT_L(n) asm volatile("s_waitcnt lgkmcnt(" #n ")" ::: "memory")
#define PG8_BAR __builtin_amdgcn_s_barrier()
#define PG8_SCHED __builtin_amdgcn_sched_barrier(0)
    Unit cur, nxt; int ui = 0;
    if (!S.next(0, cur)) return;
    f32x4 acc[2][2][4][2];
#pragma unroll
    for (int a = 0; a < 2; ++a)
#pragma unroll
        for (int b = 0; b < 2; ++b)
#pragma unroll
            for (int m = 0; m < 4; ++m)
#pragma unroll
                for (int n = 0; n < 2; ++n) acc[a][b][m][n] = (f32x4){0.f, 0.f, 0.f, 0.f};
    bf16x8 At[4][2], B0[2][2], B1[2][2];
    const char* cA = (const char*)g.A + (size_t)cur.pm * tstepA; const char* cB = (const char*)g.Bt + (size_t)cur.pn * tstepB;
    S.a_ready(cur);
    if constexpr (SP2) {
        PG8_STAGE(PG8_SB(0, 0), cB, voffB); PG8_STAGE(PG8_SB(0, 1), cB + hstepB, voffB); PG8_STAGE(PG8_SA(0, 0), cA, voffA); PG8_STAGE(PG8_SA(0, 1), cA + hstepA, voffA);
        if (wr == 1) PG8_BAR;
        PG8_WAIT_V(2); PG8_BAR;
        PG8_STAGE(PG8_SB(1, 0), cB + kstep, voffB); PG8_STAGE(PG8_SA(1, 0), cA + kstep, voffA); PG8_STAGE(PG8_SB(1, 1), cB + hstepB + kstep, voffB);
        PG8_WAIT_V(6); PG8_BAR;
    } else {
        PG8_STAGE(PG8_SB(0, 0), cB, voffB); PG8_STAGE(PG8_SA(0, 0), cA, voffA); PG8_STAGE(PG8_SB(0, 1), cB + hstepB, voffB); PG8_STAGE(PG8_SA(0, 1), cA + hstepA, voffA);
        if (wr == 1) PG8_BAR;
        PG8_WAIT_V(4); PG8_BAR;
        PG8_STAGE(PG8_SB(1, 0), cB + kstep, voffB); PG8_STAGE(PG8_SA(1, 0), cA + kstep, voffA); PG8_STAGE(PG8_SB(1, 1), cB + hstepB + kstep, voffB);
        PG8_WAIT_V(6); PG8_BAR;
    }
    for (;;) {
        const bool has_next = S.next(ui + 1, nxt);
        const char* nA = has_next ? (const char*)g.A + (size_t)nxt.pm * tstepA : cA; const char* nB = has_next ? (const char*)g.Bt + (size_t)nxt.pn * tstepB : cB;
        for (int t = 0; t < nt; t += 2) {
            const bool last = (t == nt - 2);
            const char* a1 = cA + (size_t)(t + 1) * kstep;
            const char* a2 = last ? nA : cA + (size_t)(t + 2) * kstep; const char* b2 = last ? nB : cB + (size_t)(t + 2) * kstep;
            const char* a3 = a2 + kstep; const char* b3 = b2 + kstep;
            if (last && has_next) S.a_ready(nxt);
            if constexpr (SP2) {
            PG8_LDB(B0, 0, 0); PG8_LDB(B1, 0, 1); PG8_SCHED; PG8_LDA(At, 0, 0); PG8_STAGE(PG8_SA(1, 1), a1 + hstepA, voffA);
            PG8_WAIT_V(8); PG8_WAIT_L(0); PG8_BAR; PG8_MMA(0, 0, At, B0); PG8_MMA(0, 1, At, B1); PG8_BAR; PG8_SCHED;
            PG8_LDA(At, 0, 1); PG8_STAGE(PG8_SB(0, 0), b2, voffB); PG8_STAGE(PG8_SB(0, 1), b2 + hstepB, voffB); PG8_STAGE(PG8_SA(0, 0), a2, voffA);
            PG8_WAIT_V(8); PG8_WAIT_L(0); PG8_BAR; PG8_MMA(1, 0, At, B0); PG8_MMA(1, 1, At, B1); PG8_BAR; PG8_SCHED;
            PG8_LDB(B0, 1, 0); PG8_LDB(B1, 1, 1); PG8_SCHED; PG8_LDA(At, 1, 0); PG8_STAGE(PG8_SA(0, 1), a2 + hstepA, voffA);
            PG8_WAIT_V(8); PG8_WAIT_L(0); PG8_BAR; PG8_MMA(0, 0, At, B0); PG8_MMA(0, 1, At, B1); PG8_BAR; PG8_SCHED;
            PG8_LDA(At, 1, 1); PG8_STAGE(PG8_SB(1, 0), b3, voffB); PG8_STAGE(PG8_SB(1, 1), b3 + hstepB, voffB); PG8_STAGE(PG8_SA(1, 0), a3, voffA);
            PG8_WAIT_V(8); PG8_WAIT_L(0); PG8_BAR; PG8_MMA(1, 0, At, B0); PG8_MMA(1, 1, At, B1); PG8_BAR; PG8_SCHED;
            } else {
            PG8_LDB(B0, 0, 0); PG8_SCHED; PG8_LDA(At, 0, 0); PG8_STAGE(PG8_SA(1, 1), a1 + hstepA, voffA);
            PG8_WAIT_L(8); PG8_BAR; PG8_WAIT_L(0); PG8_MMA(0, 0, At, B0); PG8_BAR; PG8_SCHED;
            PG8_LDB(B1, 0, 1); PG8_STAGE(PG8_SB(0, 0), b2, voffB);
            PG8_BAR; PG8_WAIT_L(0); PG8_MMA(0, 1, At, B1); PG8_BAR;
            PG8_LDA(At, 0, 1); PG8_STAGE(PG8_SA(0, 0), a2, voffA);
            PG8_BAR; PG8_WAIT_L(0); PG8_MMA(1, 0, At, B0); PG8_BAR; PG8_SCHED;
            PG8_STAGE(PG8_SB(0, 1), b2 + hstepB, voffB);
            PG8_WAIT_V(6); PG8_BAR; PG8_MMA(1, 1, At, B1); PG8_BAR;
            PG8_LDB(B0, 1, 0); PG8_SCHED; PG8_LDA(At, 1, 0); PG8_STAGE(PG8_SA(0, 1), a2 + hstepA, voffA);
            PG8_WAIT_L(8); PG8_BAR; PG8_WAIT_L(0); PG8_MMA(0, 0, At, B0); PG8_BAR; PG8_SCHED;
            PG8_LDB(B1, 1, 1); PG8_STAGE(PG8_SB(1, 0), b3, voffB);
            PG8_BAR; PG8_WAIT_L(0); PG8_MMA(0, 1, At, B1); PG8_BAR;
            PG8_LDA(At, 1, 1); PG8_STAGE(PG8_SA(1, 0), a3, voffA);
            PG8_BAR; PG8_WAIT_L(0); PG8_MMA(1, 0, At, B0); PG8_BAR; PG8_SCHED;
            PG8_STAGE(PG8_SB(1, 1), b3 + hstepB, voffB);
            PG8_WAIT_V(6); PG8_BAR; PG8_MMA(1, 1, At, B1); PG8_BAR;
            }
        }
        if constexpr (ALIGN_EPI) { if (wr == 0) PG8_BAR; }
        if constexpr (!Epi::AFTER_DRAIN) { E(acc, cur, wr, wc, fr, fq); S.done(cur); }
        if (!has_next) break;
#pragma unroll
        for (int a = 0; a < 2; ++a)
#pragma unroll
            for (int b = 0; b < 2; ++b)
#pragma unroll
                for (int m = 0; m < 4; ++m)
#pragma unroll
                    for (int n = 0; n < 2; ++n) acc[a][b][m][n] = (f32x4){0.f, 0.f, 0.f, 0.f};
        cur = nxt; cA = nA; cB = nB; ++ui;
        if constexpr (ALIGN_EPI) { if (wr == 1) PG8_BAR; }
    }
    PG8_WAIT_V(0);
    if constexpr (!ALIGN_EPI) { if (wr == 0) PG8_BAR; }
    PG8_BAR;
    if constexpr (Epi::AFTER_DRAIN) { E.fused(acc, cur, wr, wc, fr, fq, lds, wid, lane); S.done(cur); }
#undef PG8_SA
#undef PG8_SB
#undef PG8_STAGE
#undef PG8_LDA
#undef PG8_LDB
#undef PG8_MMA
#undef PG8_WAIT_V
#undef PG8_WAIT_L
#undef PG8_BAR
#undef PG8_SCHED
}
}
namespace pg8 {
typedef unsigned u32x2e __attribute__((ext_vector_type(2)));
struct EpiBf16P {
    static constexpr bool PERM = true, AFTER_DRAIN = false;
    bf16_t* O; int ldc;
    __device__ __forceinline__ void operator()(const f32x4 (&acc)[2][2][4][2], const Unit& u, int wr, int wc, int fr, int fq) const {
        const int row0 = u.pm * BM + wr * 64 + fr, col0 = u.pn * BM + wc * 32 + 8 * fq;
#pragma unroll
        for (int ai = 0; ai < 2; ++ai)
#pragma unroll
            for (int m = 0; m < 4; ++m) { bf16_t* rowp = O + (size_t)(row0 + ai * HALF + m * 16) * ldc + col0;
#pragma unroll
                for (int bj = 0; bj < 2; ++bj) { const f32x4 v0 = acc[ai][bj][m][0], v1 = acc[ai][bj][m][1];
                    u32x4 w; w.x = cvt_pk_bf16(v0[0], v0[1]); w.y = cvt_pk_bf16(v0[2], v0[3]); w.z = cvt_pk_bf16(v1[0], v1[1]); w.w = cvt_pk_bf16(v1[2], v1[3]);
                    *(u32x4*)(rowp + bj * HALF) = w; } }
    }
};
struct EpiF32 {
    static constexpr bool PERM = false, AFTER_DRAIN = false;
    float* O; int ldc;
    __device__ __forceinline__ void operator()(const f32x4 (&acc)[2][2][4][2], const Unit& u, int wr, int wc, int fr, int fq) const {
        const int row0 = u.pm * BM + wr * 64 + fr, col0 = u.pn * BM + wc * 32 + 4 * fq;
#pragma unroll
        for (int ai = 0; ai < 2; ++ai)
#pragma unroll
            for (int m = 0; m < 4; ++m) { float* rowp = O + (size_t)(row0 + ai * HALF + m * 16) * ldc + col0;
#pragma unroll
                for (int bj = 0; bj < 2; ++bj)
#pragma unroll
                    for (int n = 0; n < 2; ++n) *(f32x4*)(rowp + bj * HALF + n * 16) = acc[ai][bj][m][n]; }
    }
};
struct EpiL1 {
    static constexpr bool PERM = true, AFTER_DRAIN = false;
    bf16_t* dst0; bf16_t* dst1; bf16_t* dst2; bf16_t* dst3; bf16_t* d1; int Mrows;
    __device__ __forceinline__ void operator()(const f32x4 (&acc)[2][2][4][2], const Unit& u, int wr, int wc, int fr, int fq) const {
        const int p = u.pm >> 6; const int row0 = (u.pm & 63) * BM + wr * 64 + fr;
        if (p < 4) {
            bf16_t* base = (p == 0) ? dst0 : (p == 1) ? dst1 : (p == 2) ? dst2 : dst3; const int col0 = (u.pn - 4 * p) * BM + wc * 32 + 8 * fq;
#pragma unroll
            for (int ai = 0; ai < 2; ++ai)
#pragma unroll
                for (int m = 0; m < 4; ++m) { bf16_t* rowp = base + (size_t)(row0 + ai * HALF + m * 16) * 1024 + col0;
#pragma unroll
                    for (int bj = 0; bj < 2; ++bj) { const f32x4 v0 = acc[ai][bj][m][0], v1 = acc[ai][bj][m][1];
                        u32x4 w; w.x = cvt_pk_bf16(v0[0], v0[1]); w.y = cvt_pk_bf16(v0[2], v0[3]); w.z = cvt_pk_bf16(v1[0], v1[1]); w.w = cvt_pk_bf16(v1[2], v1[3]);
                        *(u32x4*)(rowp + bj * HALF) = w; } }
        } else if (wc < 2) {
            bf16_t* base = d1 + (size_t)(p - 4) * Mrows * 64; const int col0 = wc * 32 + 8 * fq;
#pragma unroll
            for (int ai = 0; ai < 2; ++ai)
#pragma unroll
                for (int m = 0; m < 4; ++m) { f32x4 v0 = acc[ai][0][m][0], v1 = acc[ai][0][m][1];
                    if (p == 4) { v0[0] = tanhf(v0[0]); v0[1] = tanhf(v0[1]); v0[2] = tanhf(v0[2]); v0[3] = tanhf(v0[3]); v1[0] = tanhf(v1[0]); v1[1] = tanhf(v1[1]); v1[2] = tanhf(v1[2]); v1[3] = tanhf(v1[3]); }
                    u32x4 w; w.x = cvt_pk_bf16(v0[0], v0[1]); w.y = cvt_pk_bf16(v0[2], v0[3]); w.z = cvt_pk_bf16(v1[0], v1[1]); w.w = cvt_pk_bf16(v1[2], v1[3]);
                    *(u32x4*)(base + (size_t)(row0 + ai * HALF + m * 16) * 64 + col0) = w; }
        }
    }
};
struct GroupOrder {
    int pm0, pn0, n0, pm1, pn1, n1, G, c;
    __device__ __forceinline__ bool map(long L, int pmb, int pnb, int nN, Unit& u) const {
        const int nwg = 64 * nN; int wgid = (int)L; { const int q = nwg / NXCD, xcd = wgid % NXCD, off = wgid / NXCD; wgid = xcd * q + off; }
        const int nig = WGM * nN, gid = wgid / nig, fm = gid * WGM;
        u.pm = pmb + fm + ((wgid % nig) % WGM); u.pn = pnb + (wgid % nig) / WGM; return true; }
    __device__ bool next(int i, Unit& u) const {
        long L = (long)i * G + c;
        if (L < 64 * n0) return map(L, pm0, pn0, n0, u);
        L -= 64 * n0;
        if (L < 64 * n1) return map(L, pm1, pn1, n1, u);
        return false;
    }
    __device__ __forceinline__ void a_ready(const Unit&) const {}
    __device__ __forceinline__ void done(const Unit&) const {}
};
}
constexpr int NWAVES = 8;
constexpr int BATCH = 2, T = 8192, D = 1024, M = BATCH * T;
constexpr int NPROJ = 6144;
constexpr int C_RGX = 0, C_HGQ = 1024, C_HGF = 2048, C_HGI = 3072, C_RGG = 4096, C_HGG = 5120;
constexpr float RMS_EPS = 1e-6f;
constexpr int NPHASE = 12;
constexpr size_t MiB = 1u << 20;
constexpr size_t WS_CTL = 0, CTL_ZERO_BYTES = 1 * MiB;
constexpr size_t WS_WIN0 = 1 * MiB;
constexpr size_t WS_WOUT0 = 13 * MiB;
constexpr size_t WS_WIN1 = 17 * MiB;
constexpr size_t WS_WOUT1 = 26 * MiB;
constexpr size_t WS_SMALL = 28 * MiB;
constexpr size_t WS_U0 = 30 * MiB;
constexpr size_t WS_BIG = 62 * MiB;
constexpr size_t WS_END = 254 * MiB;
constexpr size_t RSZ = 32 * MiB;
constexpr int CW_BAR = 4096;
constexpr int RING_OFF = 0, RING_BYTES = 131072;
constexpr int LDSCTL_OFF = RING_BYTES, MISC_OFF = LDSCTL_OFF + 320;
constexpr int LDS_BYTES = 147456;
#define GAS __attribute__((address_space(1)))
#define LAS __attribute__((address_space(3)))
typedef unsigned short bf16;
typedef unsigned v4u __attribute__((ext_vector_type(4)));
typedef float f32x4 __attribute__((ext_vector_type(4)));
typedef short bf16x8 __attribute__((ext_vector_type(8)));
typedef GAS unsigned gu32;
typedef GAS unsigned long long gu64;
#define RLX_AGENT __ATOMIC_RELAXED, __HIP_MEMORY_SCOPE_AGENT
#define LDS_WAIT() asm volatile("s_waitcnt lgkmcnt(0)" ::: "memory")
#define VM_WAIT() asm volatile("s_waitcnt vmcnt(0)" ::: "memory")
__device__ __forceinline__ unsigned long long rt() { return __builtin_amdgcn_s_memrealtime(); }
__device__ __forceinline__ unsigned f2bf(float f) { unsigned u = __builtin_bit_cast(unsigned, f); return (u + 0x7fffu + ((u >> 16) & 1u)) >> 16; }
__device__ __forceinline__ unsigned pk2(float lo, float hi) { return f2bf(lo) | (f2bf(hi) << 16); }
#define XB_TMO      128
#define XB_XCNT(j)  (256  + 64 * (j))
#define XB_XSUB(j)  (1280 + 64 * (j))
#define XB_XGEN(j)  (2304 + 64 * (j))
#define XB_TOP      3328
#define XB_TOPGEN   3392
#define XCD_BAR_WORDS 3456
#define XB_SPIN_CAP (1u << 18)

__device__ __forceinline__ unsigned xb_ld(unsigned* p)              { return __hip_atomic_load(p, __ATOMIC_RELAXED, __HIP_MEMORY_SCOPE_AGENT); }
__device__ __forceinline__ unsigned xb_add(unsigned* p, unsigned v) { return __hip_atomic_fetch_add(p, v, __ATOMIC_RELAXED, __HIP_MEMORY_SCOPE_AGENT); }
__device__ __forceinline__ unsigned xb_xcc_id() { return (unsigned)__builtin_amdgcn_s_getreg((3 << 11) | 20) & 0xFu; }
#define XB_SPIN(cond, bar) do { unsigned _sp = 0; while (cond) { __builtin_amdgcn_s_sleep(1); \
    if ((++_sp & 255u) == 0u) { if (xb_ld(&(bar)[XB_TMO])) break; if (_sp > XB_SPIN_CAP) { atomicAdd(&(bar)[XB_TMO], 1u); break; } } } } while (0)

struct XcdBarrier {
    unsigned* bar; unsigned x;
    volatile LAS unsigned* st;
};

__device__ __forceinline__ XcdBarrier xcd_barrier_post(unsigned* bar, volatile LAS unsigned* st) {
    XcdBarrier b; b.bar = bar; b.x = xb_xcc_id(); b.st = st;
    if (threadIdx.x == 0) (void)xb_add(&bar[XB_XCNT(b.x)], 1u);
    return b;
}
__device__ __forceinline__ void xcd_barrier_complete(unsigned* bar, unsigned x, unsigned& nloc, unsigned& nx) {
    const unsigned G = gridDim.x * gridDim.y * gridDim.z;
    unsigned sum, cnt, mine, sp = 0u;
    for (;;) {
        sum = 0u; cnt = 0u; mine = 0u;
#pragma unroll
        for (unsigned j = 0; j < 16; ++j) { const unsigned c = xb_ld(&bar[XB_XCNT(j)]); sum += c; cnt += (c > 0u) ? 1u : 0u; mine = (j == x) ? c : mine; }
        if (sum == G) break;
        __builtin_amdgcn_s_sleep(1);
        if ((++sp & 255u) == 0u) { if (xb_ld(&bar[XB_TMO])) break; if (sp > XB_SPIN_CAP) { atomicAdd(&bar[XB_TMO], 1u); break; } }
    }
    nloc = mine > 0u ? mine : 1u; nx = cnt > 0u ? cnt : 1u;
}

__device__ __forceinline__ void xcd_barrier(const XcdBarrier& b) {
    asm volatile("s_waitcnt vmcnt(0)" ::: "memory");
    __syncthreads();
    if (threadIdx.x == 0) {
        unsigned* bar = b.bar;
        __builtin_amdgcn_s_waitcnt(0);
        unsigned nloc = b.st[0], nx = b.st[1];
        if (nloc == 0u) { xcd_barrier_complete(bar, b.x, nloc, nx); b.st[0] = nloc; b.st[1] = nx; }
        const unsigned old = xb_add(&bar[XB_XSUB(b.x)], 1u);
        const unsigned gen = old / nloc;
        if (old + 1u == (gen + 1u) * nloc) {
            __builtin_amdgcn_fence(__ATOMIC_RELEASE, "agent");
            asm volatile("s_waitcnt vmcnt(0)" ::: "memory");
            const unsigned og = xb_add(&bar[XB_TOP], 1u);
            const unsigned tg = og / nx;
            if (og + 1u == (tg + 1u) * nx) xb_add(&bar[XB_TOPGEN], 1u);
            else XB_SPIN(xb_ld(&bar[XB_TOPGEN]) == tg, bar);
            __builtin_amdgcn_fence(__ATOMIC_ACQUIRE, "agent");
            xb_add(&bar[XB_XGEN(b.x)], 1u);
            asm volatile("s_waitcnt vmcnt(0)" ::: "memory");
        } else {
            XB_SPIN(xb_ld(&bar[XB_XGEN(b.x)]) == gen, bar);
            __builtin_amdgcn_fence(__ATOMIC_ACQUIRE, "agent");
            asm volatile("s_waitcnt vmcnt(0)" ::: "memory");
        }
    }
    __syncthreads();
}
struct Frame {
    LAS unsigned char* lds;
    volatile LAS unsigned* MISC;
    gu32* ctl;
    int tid, lane, wave;
    int vcu, G;
};
__device__ __forceinline__ float wave_sum(float v) {
#pragma unroll
    for (int o = 1; o < 64; o <<= 1) v += __shfl_xor(v, o);
    return v;
}
__device__ __forceinline__ float bf2f(bf16 u) { return __uint_as_float((unsigned)u << 16); }
__device__ __forceinline__ float sigmoidf_(float x) { return 1.f / (1.f + __expf(-x)); }
__device__ __forceinline__ float siluf_(float x) { return x / (1.f + __expf(-x)); }

__device__ __forceinline__ void p0_transpose_item(const float* W, int ldw, int c0, bf16* WT, int ldt, int row_off, int nblk, LAS float* scr, int item, int lane) {
    const int kb = item / nblk, nb = item % nblk, k0 = 64 * kb, n0 = 32 * nb;
#pragma unroll 8
    for (int i = 0; i < 32; ++i) { const int kk = 2 * i + (lane >> 5); scr[kk * 33 + (lane & 31)] = W[(size_t)(k0 + kk) * ldw + c0 + n0 + (lane & 31)]; }
    LDS_WAIT(); asm volatile("" ::: "memory");
    const int c = lane & 7;
#pragma unroll
    for (int j = 0; j < 4; ++j) { const int n = (lane >> 3) + 8 * j; const LAS float* s = scr + (8 * c) * 33 + n;
        v4u o; o.x = pk2(s[0 * 33], s[1 * 33]); o.y = pk2(s[2 * 33], s[3 * 33]); o.z = pk2(s[4 * 33], s[5 * 33]); o.w = pk2(s[6 * 33], s[7 * 33]);
        *(GAS v4u*)(WT + (size_t)(row_off + n0 + n) * ldt + k0 + 8 * c) = o; }
    LDS_WAIT(); asm volatile("" ::: "memory");
}
struct Args { const float* in[28]; float* out; unsigned char* ws; int ph_lo, ph_hi, li, pad; };
enum { I_X = 0, I_PRE, I_POST, I_ABWIN, I_ABWOUT, I_CONVW, I_CONVB, I_RGWA, I_RGBA, I_RGWX, I_RGBX, I_LAM, I_HGLB, I_HGNORM, I_MU, I_RWWIN, I_RWWOUT,
       I_W0, I_W1, I_W2, I_A0, I_A1, I_A2, I_KK, I_KA, I_RK, I_LNW, I_LNB };

__device__ __forceinline__ void rms_row_to_bf16(int lane, const float* xrow, const float* gain, bf16* orow) {
    const GAS f32x4* xr = (const GAS f32x4*)xrow + lane; const GAS f32x4* gr = (const GAS f32x4*)gain + lane;
    f32x4 v[4]; float s = 0.f;
#pragma unroll
    for (int j = 0; j < 4; ++j) { v[j] = xr[64 * j]; s += (v[j].x * v[j].x + v[j].y * v[j].y) + (v[j].z * v[j].z + v[j].w * v[j].w); }
    const float rstd = 1.f / sqrtf(wave_sum(s) * (1.f / D) + RMS_EPS);
    GAS unsigned long long* o8 = (GAS unsigned long long*)orow + lane;
#pragma unroll
    for (int j = 0; j < 4; ++j) { const f32x4 g = gr[64 * j];
        o8[64 * j] = (unsigned long long)pk2(v[j].x * rstd * g.x, v[j].y * rstd * g.y) | ((unsigned long long)pk2(v[j].z * rstd * g.z, v[j].w * rstd * g.w) << 32); }
}

__device__ __forceinline__ void p0_prologue(Frame& F, const Args& a) {
    LAS float* scr = (LAS float*)(F.lds + RING_OFF + F.wave * 16384);
    const int gw = F.vcu * NWAVES + F.wave, NGW = F.G * NWAVES;
    bf16* WIN0 = (bf16*)(a.ws + WS_WIN0); bf16* WOUT0 = (bf16*)(a.ws + WS_WOUT0); bf16* WIN1 = (bf16*)(a.ws + WS_WIN1); bf16* WOUT1 = (bf16*)(a.ws + WS_WOUT1);
    constexpr int I_BLK = 16 * 32;
    constexpr int N0 = 6 * I_BLK, N1 = N0 + 32 * 32, N2 = N1 + 4 * I_BLK, N3 = N2 + 32, N4 = N3 + 32, N5 = N4 + I_BLK;
    for (int it = gw; it < N5; it += NGW) {
        if (it < N0) { const int sb = it / I_BLK, r = it % I_BLK; const int db = (sb == 0) ? 0 : (sb == 1) ? 4 : (sb == 2) ? 1 : (sb == 3) ? 2 : (sb == 4) ? 3 : 5;
            p0_transpose_item(a.in[I_ABWIN], NPROJ, sb * 1024, WIN0, 1024, db * 1024, 32, scr, r, F.lane); }
        else if (it < N1) p0_transpose_item(a.in[I_ABWOUT], 1024, 0, WOUT0, 2048, 0, 32, scr, it - N0, F.lane);
        else if (it < N2) { const int p = (it - N1) / I_BLK, r = (it - N1) % I_BLK; p0_transpose_item(a.in[I_RWWIN] + (size_t)p * 1024 * 1024, 1024, 0, WIN1, 1024, p * 1024, 32, scr, r, F.lane); }
        else if (it < N3) p0_transpose_item(a.in[I_W1], 64, 0, WIN1, 1024, 4096, 2, scr, it - N2, F.lane);
        else if (it < N4) p0_transpose_item(a.in[I_A1], 64, 0, WIN1, 1024, 4352, 2, scr, it - N3, F.lane);
        else p0_transpose_item(a.in[I_RWWOUT], 1024, 0, WOUT1, 1024, 0, 32, scr, it - N4, F.lane);
    }
    { const int gt = gw * 64 + F.lane, NGT = NGW * 64; const v4u z = {0u, 0u, 0u, 0u};
      for (int e = gt; e < 2 * 192 * 128; e += NGT) { const int blk = e / (192 * 128), r = e % (192 * 128);
          *(GAS v4u*)(WIN1 + (size_t)(blk ? 4416 : 4160) * 1024 + (size_t)r * 8) = z; } }
    bf16* U0 = (bf16*)(a.ws + WS_U0);
    for (int m = gw; m < M; m += NGW) rms_row_to_bf16(F.lane, a.in[I_X] + (size_t)m * D, a.in[I_PRE], U0 + (size_t)m * D);
}

__device__ __forceinline__ void rg_naive(Frame& F, const Args& a, int item) {
    const int b = item >> 4, n = item & 15, j = F.lane, c = n * 64 + j;
    LAS float* xs = (LAS float*)(F.lds); LAS float* was = xs + 64; LAS float* wxs = was + 4096;
    for (int i = 0; i < 64; ++i) { was[i * 64 + j] = a.in[I_RGWA][(size_t)(n * 64 + i) * 64 + j]; wxs[i * 64 + j] = a.in[I_RGWX][(size_t)(n * 64 + i) * 64 + j]; }
    const float cw0 = a.in[I_CONVW][c], cw1 = a.in[I_CONVW][1024 + c], cw2 = a.in[I_CONVW][2048 + c], cw3 = a.in[I_CONVW][3072 + c], cb = a.in[I_CONVB][c];
    const float ba = a.in[I_RGBA][c], bx = a.in[I_RGBX][c];
    const float sp = log1pf(expf(-a.in[I_LAM][c]));
    bf16* P = (bf16*)(a.ws + WS_BIG) + (size_t)b * T * NPROJ;
    float xm1 = 0.f, xm2 = 0.f, xm3 = 0.f, h = 0.f;
    for (int t0 = 0; t0 < T; t0 += 8) {
        float xin[8], gg[8];
#pragma unroll
        for (int q = 0; q < 8; ++q) { xin[q] = bf2f(P[(size_t)(t0 + q) * NPROJ + C_RGX + c]); gg[q] = bf2f(P[(size_t)(t0 + q) * NPROJ + C_RGG + c]); }
#pragma unroll 1
        for (int q = 0; q < 8; ++q) {
            float xq = xin[0], gq = gg[0];
#pragma unroll
            for (int z = 1; z < 8; ++z) if (q == z) { xq = xin[z]; gq = gg[z]; }
            const float xc = cw0 * xm3 + cw1 * xm2 + cw2 * xm1 + cw3 * xq + cb;
            xm3 = xm2; xm2 = xm1; xm1 = xq;
            asm volatile("" ::: "memory");
            xs[j] = xc;
            asm volatile("s_waitcnt lgkmcnt(0)" ::: "memory");
            float gr = ba, gi = bx;
#pragma unroll
            for (int i = 0; i < 64; ++i) { const float xi = xs[i]; gr += xi * was[i * 64 + j]; gi += xi * wxs[i * 64 + j]; }
            asm volatile("s_waitcnt lgkmcnt(0)" ::: "memory");
            const float gate_r = sigmoidf_(gr), gate_i = sigmoidf_(gi);
            const float log_a = -8.0f * gate_r * sp;
            const float av = expf(log_a), mult = sqrtf(-expm1f(2.0f * log_a));
            h = av * h + mult * (gate_i * xc);
            P[(size_t)(t0 + q) * NPROJ + C_RGG + c] = (bf16)f2bf(h * siluf_(gq));
        }
    }
}

__device__ __forceinline__ void hg_naive(Frame& F, const Args& a, int item) {
    const int b = item >> 3, hh = item & 7, tid = F.tid, v = tid & 127, dg = __builtin_amdgcn_readfirstlane(tid >> 7);
    LAS float* qs = (LAS float*)(F.lds); LAS float* fs = qs + 2048; LAS float* ks = fs + 2048; LAS float* vs = ks + 2048; LAS float* po = vs + 2048;
    bf16* P = (bf16*)(a.ws + WS_BIG) + (size_t)b * T * NPROJ;
    float lb; { const int c = hh * 128 + v; const float l0 = a.in[I_HGLB][c], l1 = a.in[I_HGLB][1024 + c], l2 = a.in[I_HGLB][2048 + c];
        const float mx = fmaxf(l0, fmaxf(l1, l2)); const float e0 = expf(l0 - mx), e1 = expf(l1 - mx), e2 = expf(l2 - mx); lb = e1 / (e0 + e1 + e2); }
    float s[32];
#pragma unroll
    for (int i = 0; i < 32; ++i) s[i] = 0.f;
    for (int t0 = 0; t0 < T; t0 += 16) {
#pragma unroll
        for (int k = 0; k < 4; ++k) { const int t = (tid >> 7) + 4 * k; const bf16* row = P + (size_t)(t0 + t) * NPROJ + hh * 128 + v;
            const float q = bf2f(row[C_HGQ]), fr = bf2f(row[C_HGF]), vi = bf2f(row[C_HGI]);
            const float f = lb + (1.f - lb) * sigmoidf_(fr);
            qs[t * 128 + v] = siluf_(q); fs[t * 128 + v] = f; ks[t * 128 + v] = 1.f - f; vs[t * 128 + v] = vi; }
        __syncthreads();
#pragma unroll 1
        for (int t = 0; t < 16; ++t) {
            float acc = 0.f; const float vv = vs[t * 128 + v];
#pragma unroll
            for (int i = 0; i < 32; ++i) { const int d = dg * 32 + i; s[i] = fs[t * 128 + d] * s[i] + ks[t * 128 + d] * vv; acc += qs[t * 128 + d] * s[i]; }
            po[(t * 4 + dg) * 128 + v] = acc;
        }
        __syncthreads();
#pragma unroll
        for (int tt = 0; tt < 2; ++tt) { const int t = F.wave * 2 + tt;
            float o0 = 0.f, o1 = 0.f;
#pragma unroll
            for (int g = 0; g < 4; ++g) { o0 += po[(t * 4 + g) * 128 + F.lane]; o1 += po[(t * 4 + g) * 128 + 64 + F.lane]; }
            const float ss = wave_sum(o0 * o0 + o1 * o1); const float rstd = 1.f / sqrtf(ss * (1.f / 128.f) + RMS_EPS);
            bf16* row = P + (size_t)(t0 + t) * NPROJ + C_HGG + hh * 128;
            const float g0 = bf2f(row[F.lane]), g1 = bf2f(row[64 + F.lane]);
            row[F.lane] = (bf16)f2bf(o0 * rstd * a.in[I_HGNORM][F.lane] * siluf_(g0));
            row[64 + F.lane] = (bf16)f2bf(o1 * rstd * a.in[I_HGNORM][64 + F.lane] * siluf_(g1)); }
        __syncthreads();
    }
}

__device__ __forceinline__ void rw_naive(Frame& F, const Args& a, int item) {
    const int b = item >> 4, hh = item & 15, j = F.lane, c = hh * 64 + j;
    LAS float* w2s = (LAS float*)(F.lds); LAS float* a2s = w2s + 4096; LAS float* vec = a2s + 4096;
    for (int i = 0; i < 64; ++i) { w2s[i * 64 + j] = a.in[I_W2][(size_t)i * 1024 + c]; a2s[i * 64 + j] = a.in[I_A2][(size_t)i * 1024 + c]; }
    const float w0c = a.in[I_W0][c], a0c = a.in[I_A0][c], kkc = a.in[I_KK][c], kac = a.in[I_KA][c], rkc = a.in[I_RK][c], lnw = a.in[I_LNW][c], lnb = a.in[I_LNB][c];
    const bf16* Rr = (const bf16*)(a.ws + WS_BIG + 4 * RSZ) + (size_t)b * T * 1024 + c;
    const bf16* Rk = (const bf16*)(a.ws + WS_BIG + 5 * RSZ) + (size_t)b * T * 1024 + c;
    const bf16* Rv = (const bf16*)(a.ws + WS_BIG + 0 * RSZ) + (size_t)b * T * 1024 + c;
    const bf16* Rg = (const bf16*)(a.ws + WS_BIG + 1 * RSZ) + (size_t)b * T * 1024 + c;
    bf16* Z = (bf16*)(a.ws + WS_BIG + 2 * RSZ) + (size_t)b * T * 1024 + c;
    const bf16* D1w = (const bf16*)(a.ws + WS_U0) + (size_t)b * T * 64 + j;
    const bf16* D1a = (const bf16*)(a.ws + WS_U0) + (size_t)M * 64 + (size_t)b * T * 64 + j;
    float S[64];
#pragma unroll
    for (int i = 0; i < 64; ++i) S[i] = 0.f;
    asm volatile("s_waitcnt lgkmcnt(0)" ::: "memory");
    for (int t0 = 0; t0 < T; t0 += 8) {
        float pr[8], pk[8], pv[8], pg[8], pdw[8], pda[8];
#pragma unroll
        for (int q = 0; q < 8; ++q) { const size_t o = (size_t)(t0 + q) * 1024; pr[q] = bf2f(Rr[o]); pk[q] = bf2f(Rk[o]); pv[q] = bf2f(Rv[o]); pg[q] = bf2f(Rg[o]);
            pdw[q] = bf2f(D1w[(size_t)(t0 + q) * 64]); pda[q] = bf2f(D1a[(size_t)(t0 + q) * 64]); }
#pragma unroll 1
        for (int q = 0; q < 8; ++q) {
            float rr, kv, vv, gv, dw, da;
            rr = pr[0]; kv = pk[0]; vv = pv[0]; gv = pg[0]; dw = pdw[0]; da = pda[0];
#pragma unroll
            for (int z = 1; z < 8; ++z) if (q == z) { rr = pr[z]; kv = pk[z]; vv = pv[z]; gv = pg[z]; dw = pdw[z]; da = pda[z]; }
            asm volatile("" ::: "memory");
            vec[5 * 64 + j] = dw; vec[6 * 64 + j] = da;
            asm volatile("s_waitcnt lgkmcnt(0)" ::: "memory");
            float zw = w0c, za = a0c;
#pragma unroll 16
            for (int i = 0; i < 64; ++i) { zw += vec[5 * 64 + i] * w2s[i * 64 + j]; za += vec[6 * 64 + i] * a2s[i * 64 + j]; }
            const float w_log = -log1pf(expf(-zw)) - 0.5f;
            const float wdec = expf(-expf(w_log));
            const float iclr = sigmoidf_(za);
            float kkv = kv * kkc; const float nrm = sqrtf(wave_sum(kkv * kkv)); kkv = kkv / fmaxf(nrm, 1e-12f);
            const float k2 = kv * (1.f + (iclr - 1.f) * kac);
            const float bonus = wave_sum(rr * k2 * rkc);
            asm volatile("s_waitcnt lgkmcnt(0)" ::: "memory");
            vec[0 * 64 + j] = wdec; vec[1 * 64 + j] = -kkv; vec[2 * 64 + j] = kkv * iclr; vec[3 * 64 + j] = k2; vec[4 * 64 + j] = rr;
            asm volatile("s_waitcnt lgkmcnt(0)" ::: "memory");
            float sa = 0.f;
#pragma unroll
            for (int k = 0; k < 64; ++k) sa += S[k] * vec[1 * 64 + k];
            float y = 0.f;
#pragma unroll
            for (int k = 0; k < 64; ++k) { S[k] = S[k] * vec[0 * 64 + k] + sa * vec[2 * 64 + k] + vv * vec[3 * 64 + k]; y += S[k] * vec[4 * 64 + k]; }
            asm volatile("s_waitcnt lgkmcnt(0)" ::: "memory");
            const float mean = wave_sum(y) * (1.f / 64.f); const float dy = y - mean; const float var = wave_sum(dy * dy) * (1.f / 64.f);
            float yn = dy * (1.f / sqrtf(var + 64e-5f)) * lnw + lnb;
            yn += bonus * vv;
            Z[(size_t)(t0 + q) * 1024] = (bf16)f2bf(yn * siluf_(gv));
        }
    }
}
__device__ __forceinline__ void rowwise_a(Frame& F, const Args& a) {
    const int gw = F.vcu * NWAVES + F.wave, NGW = F.G * NWAVES; float* rstd1 = (float*)(a.ws + WS_SMALL);
    for (int m = gw; m < M; m += NGW) {
        const GAS f32x4* xr = (const GAS f32x4*)(a.in[I_X] + (size_t)m * D) + F.lane; GAS f32x4* mr = (GAS f32x4*)(a.out + (size_t)m * D) + F.lane;
        const GAS f32x4* gr = (const GAS f32x4*)(a.in[I_POST]) + F.lane;
        f32x4 v[4], x[4]; float s = 0.f;
#pragma unroll
        for (int j = 0; j < 4; ++j) { v[j] = mr[64 * j]; x[j] = xr[64 * j]; s += (v[j].x * v[j].x + v[j].y * v[j].y) + (v[j].z * v[j].z + v[j].w * v[j].w); }
        const float rstd = 1.f / sqrtf(wave_sum(s) * (1.f / D) + RMS_EPS); float s1 = 0.f;
#pragma unroll
        for (int j = 0; j < 4; ++j) { const f32x4 g = gr[64 * j]; f32x4 o = x[j] + v[j] * rstd * g; mr[64 * j] = o; s1 += (o.x * o.x + o.y * o.y) + (o.z * o.z + o.w * o.w); }
        const float r1 = 1.f / sqrtf(wave_sum(s1) * (1.f / D) + RMS_EPS);
        if (F.lane == 0) rstd1[m] = r1;
    }
}
__device__ __forceinline__ void rowwise_b(Frame& F, const Args& a) {
    const int gw = F.vcu * NWAVES + F.wave, NGW = F.G * NWAVES; const float* rstd1 = (const float*)(a.ws + WS_SMALL);
    for (int m = gw; m < M; m += NGW) {
        const bool first = (m % T) == 0;
        const GAS f32x4* xr = (const GAS f32x4*)(a.out + (size_t)m * D) + F.lane; const GAS f32x4* xp = (const GAS f32x4*)(a.out + (size_t)(first ? m : m - 1) * D) + F.lane;
        const GAS f32x4* gr = (const GAS f32x4*)(a.in[I_PRE] + D) + F.lane;
        const float r1 = rstd1[m], rp = first ? 0.f : rstd1[m - 1];
#pragma unroll
        for (int j = 0; j < 4; ++j) { const f32x4 g = gr[64 * j]; const f32x4 u = xr[64 * j] * r1 * g; const f32x4 up = xp[64 * j] * rp * g; const f32x4 dlt = up - u;
#pragma unroll
            for (int p = 0; p < 6; ++p) { const f32x4 mu = ((const GAS f32x4*)(a.in[I_MU] + p * D) + F.lane)[64 * j]; const f32x4 o = u + dlt * mu;
                GAS unsigned long long* o8 = (GAS unsigned long long*)((bf16*)(a.ws + WS_BIG + (size_t)p * RSZ) + (size_t)m * D) + F.lane;
                o8[64 * j] = (unsigned long long)pk2(o.x, o.y) | ((unsigned long long)pk2(o.z, o.w) << 32); } }
    }
}
__device__ __forceinline__ void rowwise_final(Frame& F, const Args& a) {
    const int gw = F.vcu * NWAVES + F.wave, NGW = F.G * NWAVES; const float* mix1 = (const float*)(a.ws + WS_BIG + 4 * RSZ);
    for (int m = gw; m < M; m += NGW) {
        GAS f32x4* xr = (GAS f32x4*)(a.out + (size_t)m * D) + F.lane; const GAS f32x4* mr = (const GAS f32x4*)(mix1 + (size_t)m * D) + F.lane;
        const GAS f32x4* gr = (const GAS f32x4*)(a.in[I_POST] + D) + F.lane;
        f32x4 v[4]; float s = 0.f;
#pragma unroll
        for (int j = 0; j < 4; ++j) { v[j] = mr[64 * j]; s += (v[j].x * v[j].x + v[j].y * v[j].y) + (v[j].z * v[j].z + v[j].w * v[j].w); }
        const float rstd = 1.f / sqrtf(wave_sum(s) * (1.f / D) + RMS_EPS);
#pragma unroll
        for (int j = 0; j < 4; ++j) { const f32x4 g = gr[64 * j]; xr[64 * j] = xr[64 * j] + v[j] * rstd * g; }
    }
}

__global__ void __launch_bounds__(NWAVES * 64, 2) mk_fwd(Args args) {
    extern __shared__ __attribute__((aligned(16))) unsigned char lds[];
    Frame F;
    F.lds = (LAS unsigned char*)lds;
    F.MISC = (volatile LAS unsigned*)(F.lds + MISC_OFF);
    F.tid = threadIdx.x; F.lane = F.tid & 63; F.wave = __builtin_amdgcn_readfirstlane(F.tid >> 6);
    F.G = gridDim.x; { const int bx = blockIdx.x; F.vcu = (F.G % 8 == 0) ? (bx % 8) * (F.G / 8) + bx / 8 : bx; }
    unsigned char* ws = args.ws;
    F.ctl = (gu32*)(ws + WS_CTL);
    for (int u = F.tid; u < (LDS_BYTES - LDSCTL_OFF) / 4; u += NWAVES * 64) ((LAS unsigned*)(F.lds + LDSCTL_OFF))[u] = 0u;
    __syncthreads();
    XcdBarrier bar; bar.bar = (unsigned*)(F.ctl + CW_BAR); bar.x = 0; bar.st = nullptr;
#if MK_ONE_LAUNCH
    bar = xcd_barrier_post((unsigned*)(F.ctl + CW_BAR), F.MISC + 8);
#define GRID_BAR() xcd_barrier(bar)
#else
#define GRID_BAR() do { } while (0)
#endif
    const int lo = args.ph_lo, hi = args.ph_hi;
#define IN(k) (lo <= (k) && (k) < hi)
#define BOTH(k) (IN(k) && IN((k) + 1))
    bf16* const BIG = (bf16*)(ws + WS_BIG);

    if (IN(0)) { p0_prologue(F, args); if (BOTH(0)) GRID_BAR(); }
    if (IN(1)) {
        pg8::Gemm g{(const bf16*)(ws + WS_U0), (const bf16*)(ws + WS_WIN0), M, NPROJ, D, D}; pg8::StaticOrder S; S.init(M, NPROJ, F.G, (int)blockIdx.x);
        pg8::EpiBf16P E{BIG, NPROJ};
        pg8::gemm_phase<pg8::EpiBf16P, pg8::StaticOrder, true, true>(F.lds + RING_OFF, g, S, E);
        if (BOTH(1)) GRID_BAR();
    }
    if (IN(2)) {
        const int bx = blockIdx.x;
        if (bx < 32) { if (F.wave == 0) rg_naive(F, args, bx); }
        else if (bx < 48) hg_naive(F, args, bx - 32);
        if (BOTH(2)) GRID_BAR();
    }
    if (IN(3)) {
        pg8::Gemm g{BIG + C_RGG, (const bf16*)(ws + WS_WOUT0), M, D, 2048, NPROJ}; pg8::StaticOrder S; S.init(M, D, F.G, (int)blockIdx.x);
        pg8::EpiF32 E{args.out, D};
        pg8::gemm_phase<pg8::EpiF32, pg8::StaticOrder, true, true>(F.lds + RING_OFF, g, S, E);
        if (BOTH(3)) GRID_BAR();
    }
    if (IN(4)) { rowwise_a(F, args); if (BOTH(4)) GRID_BAR(); }
    if (IN(5)) { rowwise_b(F, args); if (BOTH(5)) GRID_BAR(); }
    {
        pg8::EpiL1 E; E.dst0 = BIG + 4 * (RSZ / 2); E.dst1 = BIG + 5 * (RSZ / 2); E.dst2 = BIG; E.dst3 = BIG + 1 * (RSZ / 2); E.d1 = (bf16*)(ws + WS_U0); E.Mrows = M;
        pg8::Gemm g{BIG, (const bf16*)(ws + WS_WIN1), 6 * M, 4608, D, D};
        if (IN(6)) { pg8::GroupOrder S; S.pm0 = 256; S.pn0 = 16; S.n0 = 1; S.pm1 = 320; S.pn1 = 17; S.n1 = 1; S.G = F.G; S.c = (int)blockIdx.x;
            pg8::gemm_phase<pg8::EpiL1, pg8::GroupOrder, true, true>(F.lds + RING_OFF, g, S, E); if (BOTH(6)) GRID_BAR(); }
        if (IN(7)) { pg8::GroupOrder S; S.pm0 = 0; S.pn0 = 0; S.n0 = 4; S.pm1 = 64; S.pn1 = 4; S.n1 = 4; S.G = F.G; S.c = (int)blockIdx.x;
            pg8::gemm_phase<pg8::EpiL1, pg8::GroupOrder, true, true>(F.lds + RING_OFF, g, S, E); if (BOTH(7)) GRID_BAR(); }
        if (IN(8)) { pg8::GroupOrder S; S.pm0 = 128; S.pn0 = 8; S.n0 = 4; S.pm1 = 192; S.pn1 = 12; S.n1 = 4; S.G = F.G; S.c = (int)blockIdx.x;
            pg8::gemm_phase<pg8::EpiL1, pg8::GroupOrder, true, true>(F.lds + RING_OFF, g, S, E); if (BOTH(8)) GRID_BAR(); }
    }
    if (IN(9)) { if (blockIdx.x < 32 && F.wave == 0) rw_naive(F, args, (int)blockIdx.x); if (BOTH(9)) GRID_BAR(); }
    if (IN(10)) {
        pg8::Gemm g{BIG + 2 * (RSZ / 2), (const bf16*)(ws + WS_WOUT1), M, D, D, D}; pg8::StaticOrder S; S.init(M, D, F.G, (int)blockIdx.x);
        pg8::EpiF32 E{(float*)(ws + WS_BIG + 4 * RSZ), D};
        pg8::gemm_phase<pg8::EpiF32, pg8::StaticOrder, true, true>(F.lds + RING_OFF, g, S, E);
        if (BOTH(10)) GRID_BAR();
    }
    if (IN(11)) rowwise_final(F, args);
#undef IN
#undef BOTH
}

extern "C" void kernel_launch(void* const* d_in, const int* in_sizes, int n_in, void* d_out, int out_size, void* d_ws, size_t ws_size, hipStream_t stream) {
    static int grid = 0;
    if (grid == 0) {
        if (n_in != 28 || in_sizes[0] != M * D || out_size != M * D || ws_size < WS_END) { fprintf(stderr, "kernel_launch: unexpected shapes/workspace (n_in %d, ws %zu)\n", n_in, ws_size); grid = -1; return; }
        int dev = 0, cus = 0, per_cu = 0;
        if (hipGetDevice(&dev) != hipSuccess || hipDeviceGetAttribute(&cus, hipDeviceAttributeMultiprocessorCount, dev) != hipSuccess) { grid = -1; return; }
        if (hipFuncSetAttribute((const void*)mk_fwd, hipFuncAttributeMaxDynamicSharedMemorySize, LDS_BYTES) != hipSuccess) { fprintf(stderr, "kernel_launch: hipFuncSetAttribute failed\n"); grid = -1; return; }
        if (hipOccupancyMaxActiveBlocksPerMultiprocessor(&per_cu, (const void*)mk_fwd, NWAVES * 64, LDS_BYTES) != hipSuccess || per_cu < 1) fprintf(stderr, "kernel_launch: occupancy query reports %d\n", per_cu);
        (void)hipGetLastError();
        grid = cus;
    }
    if (grid < 0) return;
    if (hipMemsetAsync((char*)d_ws + WS_CTL, 0, CTL_ZERO_BYTES, stream) != hipSuccess) return;
    Args a{};
    for (int i = 0; i < 28; ++i) a.in[i] = (const float*)d_in[i];
    a.out = (float*)d_out; a.ws = (unsigned char*)d_ws;
#if MK_ONE_LAUNCH
    a.ph_lo = 0; a.ph_hi = NPHASE; a.li = 0;
    hipLaunchKernelGGL(mk_fwd, dim3(grid), dim3(NWAVES * 64), LDS_BYTES, stream, a);
#else
    for (int li = 0; li < NPHASE; ++li) { a.ph_lo = li; a.ph_hi = li + 1; a.li = li;
        hipLaunchKernelGGL(mk_fwd, dim3(grid), dim3(NWAVES * 64), LDS_BYTES, stream, a); }
#endif
}
```

```cpp
#include <hip/hip_runtime.h>
#include <cstdio>
#include <cstdint>
#include <cmath>
#ifndef MK_ONE_LAUNCH
#define MK_ONE_LAUNCH 1
#endif
namespace pg8 {
#define PG8_LAS __attribute__((address_space(3)))
typedef unsigned short bf16_t;
typedef short bf16x8 __attribute__((ext_vector_type(8)));
typedef float f32x4 __attribute__((ext_vector_type(4)));
typedef unsigned u32x4 __attribute__((ext_vector_type(4)));
constexpr int BM = 256, BK = 64, HALF = 128, HTB = HALF * BK * 2  , STAGE_BYTES = 8 * HTB, NXCD = 8, WGM = 8;

__host__ __device__ __forceinline__ int lds_byte(int r, int c) { const int st = (r >> 4) * 2 + (c >> 5), rr = r & 15, cc = c & 31, ob = rr * 64 + cc * 2; return st * 1024 + (ob ^ (((ob >> 9) & 1) << 5)); }
__host__ __device__ __forceinline__ void stage_rc(int b, int& R, int& C) { const int st = b / 1024, sb = b % 1024, swz = sb ^ (((sb >> 9) & 1) << 5); R = (st >> 1) * 16 + swz / 64; C = (st & 1) * 32 + (swz % 64) / 2; }
__host__ __device__ __forceinline__ int perm32(int rho) { const int n = rho >> 4, i = rho & 15; return 8 * (i >> 2) + 4 * n + (i & 3); }

struct Unit { int pm, pn; };
struct Gemm { const bf16_t* A; const bf16_t* Bt; int M, N, K, lda; };

struct StaticOrder {
    int nM, nN, nwg, G, c;
    __host__ __device__ void init(int M, int N, int G_, int c_) { nM = M / BM; nN = N / BM; nwg = nM * nN; G = G_; c = c_; }
    __host__ __device__ bool next(int i, Unit& u) const {
        const long L = (long)i * G + c; if (L >= nwg) return false;
        int wgid = (int)L; { const int q = nwg / NXCD, r = nwg % NXCD, xcd = wgid % NXCD, off = wgid / NXCD; wgid = (xcd < r ? xcd * (q + 1) : r * (q + 1) + (xcd - r) * q) + off; }
        const int nig = WGM * nN, gid = wgid / nig, fm = gid * WGM, gsz = (nM - fm) < WGM ? (nM - fm) : WGM;
        u.pm = fm + ((wgid % nig) % gsz); u.pn = (wgid % nig) / gsz; return true;
    }
    __device__ __forceinline__ void a_ready(const Unit&) const {}
    __device__ __forceinline__ void done(const Unit&) const {}
};

__device__ __forceinline__ unsigned cvt_pk_bf16(float lo, float hi) { unsigned r; asm volatile("v_cvt_pk_bf16_f32 %0, %1, %2" : "=v"(r) : "v"(lo), "v"(hi)); return r; }
typedef float f32x2 __attribute__((ext_vector_type(2)));
template <class Epi, class Sched, bool ALIGN_EPI = false, bool SP2 = false>
__device__ __forceinline__ void gemm_phase(PG8_LAS unsigned char* lds, const Gemm g, const Sched& S, const Epi& E) {
    const int tid = threadIdx.x, wid = __builtin_amdgcn_readfirstlane(tid >> 6), lane = tid & 63, wr = wid >> 2, wc = wid & 3, fr = lane & 15, fq = lane >> 4;
    const int K = g.K, nt = K / BK;
    unsigned voffA[2], voffB[2];
#pragma unroll
    for (int i = 0; i < 2; ++i) { int R, C; stage_rc(tid * 16 + i * 8192, R, C); const int Rb = Epi::PERM ? ((R & ~31) + perm32(R & 31)) : R;
        voffA[i] = (unsigned)(R * g.lda + C) * 2u; voffB[i] = (unsigned)(Rb * K + C) * 2u; }
    const size_t kstep = (size_t)(BK * 2);
    const size_t hstepA = (size_t)HALF * g.lda * 2, hstepB = (size_t)HALF * K * 2;
    const size_t tstepA = 2 * hstepA, tstepB = 2 * hstepB;
    const unsigned ldsw = (unsigned)wid * 1024u;
    const int aoff = lds_byte(wr * 64 + fr, fq * 8), boff = lds_byte(wc * 32 + fr, fq * 8);
#define PG8_SA(b, h) (((b) * 2 + (h)) * HTB)
#define PG8_SB(b, h) ((4 + (b) * 2 + (h)) * HTB)
#define PG8_STAGE(bufoff, gbase, voff) do { _Pragma("unroll") for (int _i = 0; _i < 2; ++_i) \
        __builtin_amdgcn_global_load_lds((const unsigned*)((const char*)(gbase) + (voff)[_i]), (PG8_LAS unsigned*)(lds + (bufoff) + ldsw + _i * 8192), 16, 0, 0); } while (0)
#define PG8_LDA(dst, b, h) do { _Pragma("unroll") for (int m = 0; m < 4; ++m) _Pragma("unroll") for (int k = 0; k < 2; ++k) dst[m][k] = *(const PG8_LAS bf16x8*)(lds + PG8_SA(b, h) + aoff + m * 2048 + k * 1024); } while (0)
#define PG8_LDB(dst, b, h) do { _Pragma("unroll") for (int n = 0; n < 2; ++n) _Pragma("unroll") for (int k = 0; k < 2; ++k) dst[n][k] = *(const PG8_LAS bf16x8*)(lds + PG8_SB(b, h) + boff + n * 2048 + k * 1024); } while (0)
#define PG8_MMA(ai, bj, At, Bt) do { __builtin_amdgcn_s_setprio(1); _Pragma("unroll") for (int m = 0; m < 4; ++m) _Pragma("unroll") for (int n = 0; n < 2; ++n) _Pragma("unroll") for (int k = 0; k < 2; ++k) \
        acc[ai][bj][m][n] = __builtin_amdgcn_mfma_f32_16x16x32_bf16(Bt[n][k], At[m][k], acc[ai][bj][m][n], 0, 0, 0); __builtin_amdgcn_s_setprio(0); } while (0)
#define PG8_WAIT_V(n) asm volatile("s_waitcnt vmcnt(" #n ")" ::: "memory")
#define PG8_WAIT_L(n) asm volatile("s_waitcnt lgkmcnt(" #n ")" ::: "memory")
#define PG8_BAR __builtin_amdgcn_s_barrier()
#define PG8_SCHED __builtin_amdgcn_sched_barrier(0)
    Unit cur, nxt; int ui = 0;
    if (!S.next(0, cur)) return;
    f32x4 acc[2][2][4][2];
#pragma unroll
    for (int a = 0; a < 2; ++a)
#pragma unroll
        for (int b = 0; b < 2; ++b)
#pragma unroll
            for (int m = 0; m < 4; ++m)
#pragma unroll
                for (int n = 0; n < 2; ++n) acc[a][b][m][n] = (f32x4){0.f, 0.f, 0.f, 0.f};
    bf16x8 At[4][2], B0[2][2], B1[2][2];
    const char* cA = (const char*)g.A + (size_t)cur.pm * tstepA; const char* cB = (const char*)g.Bt + (size_t)cur.pn * tstepB;
    S.a_ready(cur);
    if constexpr (SP2) {
        PG8_STAGE(PG8_SB(0, 0), cB, voffB); PG8_STAGE(PG8_SB(0, 1), cB + hstepB, voffB); PG8_STAGE(PG8_SA(0, 0), cA, voffA); PG8_STAGE(PG8_SA(0, 1), cA + hstepA, voffA);
        if (wr == 1) PG8_BAR;
        PG8_WAIT_V(2); PG8_BAR;
        PG8_STAGE(PG8_SB(1, 0), cB + kstep, voffB); PG8_STAGE(PG8_SA(1, 0), cA + kstep, voffA); PG8_STAGE(PG8_SB(1, 1), cB + hstepB + kstep, voffB);
        PG8_WAIT_V(6); PG8_BAR;
    } else {
        PG8_STAGE(PG8_SB(0, 0), cB, voffB); PG8_STAGE(PG8_SA(0, 0), cA, voffA); PG8_STAGE(PG8_SB(0, 1), cB + hstepB, voffB); PG8_STAGE(PG8_SA(0, 1), cA + hstepA, voffA);
        if (wr == 1) PG8_BAR;
        PG8_WAIT_V(4); PG8_BAR;
        PG8_STAGE(PG8_SB(1, 0), cB + kstep, voffB); PG8_STAGE(PG8_SA(1, 0), cA + kstep, voffA); PG8_STAGE(PG8_SB(1, 1), cB + hstepB + kstep, voffB);
        PG8_WAIT_V(6); PG8_BAR;
    }
    for (;;) {
        const bool has_next = S.next(ui + 1, nxt);
        const char* nA = has_next ? (const char*)g.A + (size_t)nxt.pm * tstepA : cA; const char* nB = has_next ? (const char*)g.Bt + (size_t)nxt.pn * tstepB : cB;
        for (int t = 0; t < nt; t += 2) {
            const bool last = (t == nt - 2);
            const char* a1 = cA + (size_t)(t + 1) * kstep;
            const char* a2 = last ? nA : cA + (size_t)(t + 2) * kstep; const char* b2 = last ? nB : cB + (size_t)(t + 2) * kstep;
            const char* a3 = a2 + kstep; const char* b3 = b2 + kstep;
            if (last && has_next) S.a_ready(nxt);
            if constexpr (SP2) {
            PG8_LDB(B0, 0, 0); PG8_LDB(B1, 0, 1); PG8_SCHED; PG8_LDA(At, 0, 0); PG8_STAGE(PG8_SA(1, 1), a1 + hstepA, voffA);
            PG8_WAIT_V(8); PG8_WAIT_L(0); PG8_BAR; PG8_MMA(0, 0, At, B0); PG8_MMA(0, 1, At, B1); PG8_BAR; PG8_SCHED;
            PG8_LDA(At, 0, 1); PG8_STAGE(PG8_SB(0, 0), b2, voffB); PG8_STAGE(PG8_SB(0, 1), b2 + hstepB, voffB); PG8_STAGE(PG8_SA(0, 0), a2, voffA);
            PG8_WAIT_V(8); PG8_WAIT_L(0); PG8_BAR; PG8_MMA(1, 0, At, B0); PG8_MMA(1, 1, At, B1); PG8_BAR; PG8_SCHED;
            PG8_LDB(B0, 1, 0); PG8_LDB(B1, 1, 1); PG8_SCHED; PG8_LDA(At, 1, 0); PG8_STAGE(PG8_SA(0, 1), a2 + hstepA, voffA);
            PG8_WAIT_V(8); PG8_WAIT_L(0); PG8_BAR; PG8_MMA(0, 0, At, B0); PG8_MMA(0, 1, At, B1); PG8_BAR; PG8_SCHED;
            PG8_LDA(At, 1, 1); PG8_STAGE(PG8_SB(1, 0), b3, voffB); PG8_STAGE(PG8_SB(1, 1), b3 + hstepB, voffB); PG8_STAGE(PG8_SA(1, 0), a3, voffA);
            PG8_WAIT_V(8); PG8_WAIT_L(0); PG8_BAR; PG8_MMA(1, 0, At, B0); PG8_MMA(1, 1, At, B1); PG8_BAR; PG8_SCHED;
            } else {
            PG8_LDB(B0, 0, 0); PG8_SCHED; PG8_LDA(At, 0, 0); PG8_STAGE(PG8_SA(1, 1), a1 + hstepA, voffA);
            PG8_WAIT_L(8); PG8_BAR; PG8_WAIT_L(0); PG8_MMA(0, 0, At, B0); PG8_BAR; PG8_SCHED;
            PG8_LDB(B1, 0, 1); PG8_STAGE(PG8_SB(0, 0), b2, voffB);
            PG8_BAR; PG8_WAIT_L(0); PG8_MMA(0, 1, At, B1); PG8_BAR;
            PG8_LDA(At, 0, 1); PG8_STAGE(PG8_SA(0, 0), a2, voffA);
            PG8_BAR; PG8_WAIT_L(0); PG8_MMA(1, 0, At, B0); PG8_BAR; PG8_SCHED;
            PG8_STAGE(PG8_SB(0, 1), b2 + hstepB, voffB);
            PG8_WAIT_V(6); PG8_BAR; PG8_MMA(1, 1, At, B1); PG8_BAR;
            PG8_LDB(B0, 1, 0); PG8_SCHED; PG8_LDA(At, 1, 0); PG8_STAGE(PG8_SA(0, 1), a2 + hstepA, voffA);
            PG8_WAIT_L(8); PG8_BAR; PG8_WAIT_L(0); PG8_MMA(0, 0, At, B0); PG8_BAR; PG8_SCHED;
            PG8_LDB(B1, 1, 1); PG8_STAGE(PG8_SB(1, 0), b3, voffB);
            PG8_BAR; PG8_WAIT_L(0); PG8_MMA(0, 1, At, B1); PG8_BAR;
            PG8_LDA(At, 1, 1); PG8_STAGE(PG8_SA(1, 0), a3, voffA);
            PG8_BAR; PG8_WAIT_L(0); PG8_MMA(1, 0, At, B0); PG8_BAR; PG8_SCHED;
            PG8_STAGE(PG8_SB(1, 1), b3 + hstepB, voffB);
            PG8_WAIT_V(6); PG8_BAR; PG8_MMA(1, 1, At, B1); PG8_BAR;
            }
        }
        if constexpr (ALIGN_EPI) { if (wr == 0) PG8_BAR; }
        if constexpr (!Epi::AFTER_DRAIN) { E(acc, cur, wr, wc, fr, fq); S.done(cur); }
        if (!has_next) break;
#pragma unroll
        for (int a = 0; a < 2; ++a)
#pragma unroll
            for (int b = 0; b < 2; ++b)
#pragma unroll
                for (int m = 0; m < 4; ++m)
#pragma unroll
                    for (int n = 0; n < 2; ++n) acc[a][b][m][n] = (f32x4){0.f, 0.f, 0.f, 0.f};
        cur = nxt; cA = nA; cB = nB; ++ui;
        if constexpr (ALIGN_EPI) { if (wr == 1) PG8_BAR; }
    }
    PG8_WAIT_V(0);
    if constexpr (!ALIGN_EPI) { if (wr == 0) PG8_BAR; }
    PG8_BAR;
    if constexpr (Epi::AFTER_DRAIN) { E.fused(acc, cur, wr, wc, fr, fq, lds, wid, lane); S.done(cur); }
#undef PG8_SA
#undef PG8_SB
#undef PG8_STAGE
#undef PG8_LDA
#undef PG8_LDB
#undef PG8_MMA
#undef PG8_WAIT_V
#undef PG8_WAIT_L
#undef PG8_BAR
#undef PG8_SCHED
}
}
namespace pg8 {
typedef unsigned u32x2e __attribute__((ext_vector_type(2)));
struct EpiBf16P {
    static constexpr bool PERM = true, AFTER_DRAIN = false;
    bf16_t* O; int ldc;
    __device__ __forceinline__ void operator()(const f32x4 (&acc)[2][2][4][2], const Unit& u, int wr, int wc, int fr, int fq) const {
        const int row0 = u.pm * BM + wr * 64 + fr, col0 = u.pn * BM + wc * 32 + 8 * fq;
#pragma unroll
        for (int ai = 0; ai < 2; ++ai)
#pragma unroll
            for (int m = 0; m < 4; ++m) { bf16_t* rowp = O + (size_t)(row0 + ai * HALF + m * 16) * ldc + col0;
#pragma unroll
                for (int bj = 0; bj < 2; ++bj) { const f32x4 v0 = acc[ai][bj][m][0], v1 = acc[ai][bj][m][1];
                    u32x4 w; w.x = cvt_pk_bf16(v0[0], v0[1]); w.y = cvt_pk_bf16(v0[2], v0[3]); w.z = cvt_pk_bf16(v1[0], v1[1]); w.w = cvt_pk_bf16(v1[2], v1[3]);
                    *(u32x4*)(rowp + bj * HALF) = w; } }
    }
};
struct EpiF32 {
    static constexpr bool PERM = false, AFTER_DRAIN = false;
    float* O; int ldc;
    __device__ __forceinline__ void operator()(const f32x4 (&acc)[2][2][4][2], const Unit& u, int wr, int wc, int fr, int fq) const {
        const int row0 = u.pm * BM + wr * 64 + fr, col0 = u.pn * BM + wc * 32 + 4 * fq;
#pragma unroll
        for (int ai = 0; ai < 2; ++ai)
#pragma unroll
            for (int m = 0; m < 4; ++m) { float* rowp = O + (size_t)(row0 + ai * HALF + m * 16) * ldc + col0;
#pragma unroll
                for (int bj = 0; bj < 2; ++bj)
#pragma unroll
                    for (int n = 0; n < 2; ++n) *(f32x4*)(rowp + bj * HALF + n * 16) = acc[ai][bj][m][n]; }
    }
};
struct EpiL1 {
    static constexpr bool PERM = true, AFTER_DRAIN = false;
    bf16_t* dst0; bf16_t* dst1; bf16_t* dst2; bf16_t* dst3; bf16_t* d1; int Mrows;
    __device__ __forceinline__ void operator()(const f32x4 (&acc)[2][2][4][2], const Unit& u, int wr, int wc, int fr, int fq) const {
        const int p = u.pm >> 6; const int row0 = (u.pm & 63) * BM + wr * 64 + fr;
        if (p < 4) {
            bf16_t* base = (p == 0) ? dst0 : (p == 1) ? dst1 : (p == 2) ? dst2 : dst3; const int col0 = (u.pn - 4 * p) * BM + wc * 32 + 8 * fq;
#pragma unroll
            for (int ai = 0; ai < 2; ++ai)
#pragma unroll
                for (int m = 0; m < 4; ++m) { bf16_t* rowp = base + (size_t)(row0 + ai * HALF + m * 16) * 1024 + col0;
#pragma unroll
                    for (int bj = 0; bj < 2; ++bj) { const f32x4 v0 = acc[ai][bj][m][0], v1 = acc[ai][bj][m][1];
                        u32x4 w; w.x = cvt_pk_bf16(v0[0], v0[1]); w.y = cvt_pk_bf16(v0[2], v0[3]); w.z = cvt_pk_bf16(v1[0], v1[1]); w.w = cvt_pk_bf16(v1[2], v1[3]);
                        *(u32x4*)(rowp + bj * HALF) = w; } }
        } else if (wc < 2) {
            bf16_t* base = d1 + (size_t)(p - 4) * Mrows * 64; const int col0 = wc * 32 + 8 * fq;
#pragma unroll
            for (int ai = 0; ai < 2; ++ai)
#pragma unroll
                for (int m = 0; m < 4; ++m) { f32x4 v0 = acc[ai][0][m][0], v1 = acc[ai][0][m][1];
                    if (p == 4) { v0[0] = tanhf(v0[0]); v0[1] = tanhf(v0[1]); v0[2] = tanhf(v0[2]); v0[3] = tanhf(v0[3]); v1[0] = tanhf(v1[0]); v1[1] = tanhf(v1[1]); v1[2] = tanhf(v1[2]); v1[3] = tanhf(v1[3]); }
                    u32x4 w; w.x = cvt_pk_bf16(v0[0], v0[1]); w.y = cvt_pk_bf16(v0[2], v0[3]); w.z = cvt_pk_bf16(v1[0], v1[1]); w.w = cvt_pk_bf16(v1[2], v1[3]);
                    *(u32x4*)(base + (size_t)(row0 + ai * HALF + m * 16) * 64 + col0) = w; }
        }
    }
};
struct GroupOrder {
    int pm0, pn0, n0, pm1, pn1, n1, G, c;
    __device__ __forceinline__ bool map(long L, int pmb, int pnb, int nN, Unit& u) const {
        const int nwg = 64 * nN; int wgid = (int)L; { const int q = nwg / NXCD, xcd = wgid % NXCD, off = wgid / NXCD; wgid = xcd * q + off; }
        const int nig = WGM * nN, gid = wgid / nig, fm = gid * WGM;
        u.pm = pmb + fm + ((wgid % nig) % WGM); u.pn = pnb + (wgid % nig) / WGM; return true; }
    __device__ bool next(int i, Unit& u) const {
        long L = (long)i * G + c;
        if (L < 64 * n0) return map(L, pm0, pn0, n0, u);
        L -= 64 * n0;
        if (L < 64 * n1) return map(L, pm1, pn1, n1, u);
        return false;
    }
    __device__ __forceinline__ void a_ready(const Unit&) const {}
    __device__ __forceinline__ void done(const Unit&) const {}
};
}
constexpr int NWAVES = 8;
constexpr int BATCH = 2, T = 8192, D = 1024, M = BATCH * T;
constexpr int NPROJ = 6144;
constexpr int C_RGX = 0, C_HGQ = 1024, C_HGF = 2048, C_HGI = 3072, C_RGG = 4096, C_HGG = 5120;
constexpr float RMS_EPS = 1e-6f;
constexpr int NPHASE = 16;
constexpr size_t MiB = 1u << 20;
constexpr size_t WS_CTL = 0, CTL_ZERO_BYTES = 1 * MiB;
constexpr size_t WS_WIN0 = 1 * MiB;
constexpr size_t WS_WOUT0 = 13 * MiB;
constexpr size_t WS_WIN1 = 17 * MiB;
constexpr size_t WS_WOUT1 = 26 * MiB;
constexpr size_t WS_SMALL = 28 * MiB;
constexpr size_t WS_U0 = 30 * MiB;
constexpr size_t WS_BIG = 62 * MiB;
constexpr size_t WS_END = 254 * MiB;
constexpr size_t RSZ = 32 * MiB;
constexpr int CW_BAR = 4096;
constexpr int RING_OFF = 0, RING_BYTES = 131072;
constexpr int LDSCTL_OFF = RING_BYTES, MISC_OFF = LDSCTL_OFF + 320;
constexpr int LDS_BYTES = 147456;
#define GAS __attribute__((address_space(1)))
#define LAS __attribute__((address_space(3)))
typedef unsigned short bf16;
typedef unsigned v4u __attribute__((ext_vector_type(4)));
typedef float f32x4 __attribute__((ext_vector_type(4)));
typedef short bf16x8 __attribute__((ext_vector_type(8)));
typedef GAS unsigned gu32;
typedef GAS unsigned long long gu64;
#define RLX_AGENT __ATOMIC_RELAXED, __HIP_MEMORY_SCOPE_AGENT
#define LDS_WAIT() asm volatile("s_waitcnt lgkmcnt(0)" ::: "memory")
#define VM_WAIT() asm volatile("s_waitcnt vmcnt(0)" ::: "memory")
__device__ __forceinline__ unsigned long long rt() { return __builtin_amdgcn_s_memrealtime(); }
__device__ __forceinline__ unsigned f2bf(float f) { unsigned u = __builtin_bit_cast(unsigned, f); return (u + 0x7fffu + ((u >> 16) & 1u)) >> 16; }
__device__ __forceinline__ unsigned pk2(float lo, float hi) { return f2bf(lo) | (f2bf(hi) << 16); }
#define XB_TMO      128
#define XB_XCNT(j)  (256  + 64 * (j))
#define XB_XSUB(j)  (1280 + 64 * (j))
#define XB_XGEN(j)  (2304 + 64 * (j))
#define XB_TOP      3328
#define XB_TOPGEN   3392
#define XCD_BAR_WORDS 3456
#define XB_SPIN_CAP (1u << 18)

__device__ __forceinline__ unsigned xb_ld(unsigned* p)              { return __hip_atomic_load(p, __ATOMIC_RELAXED, __HIP_MEMORY_SCOPE_AGENT); }
__device__ __forceinline__ unsigned xb_add(unsigned* p, unsigned v) { return __hip_atomic_fetch_add(p, v, __ATOMIC_RELAXED, __HIP_MEMORY_SCOPE_AGENT); }
__device__ __forceinline__ unsigned xb_xcc_id() { return (unsigned)__builtin_amdgcn_s_getreg((3 << 11) | 20) & 0xFu; }
#define XB_SPIN(cond, bar) do { unsigned _sp = 0; while (cond) { __builtin_amdgcn_s_sleep(1); \
    if ((++_sp & 255u) == 0u) { if (xb_ld(&(bar)[XB_TMO])) break; if (_sp > XB_SPIN_CAP) { atomicAdd(&(bar)[XB_TMO], 1u); break; } } } } while (0)

struct XcdBarrier {
    unsigned* bar; unsigned x;
    volatile LAS unsigned* st;
};

__device__ __forceinline__ XcdBarrier xcd_barrier_post(unsigned* bar, volatile LAS unsigned* st) {
    XcdBarrier b; b.bar = bar; b.x = xb_xcc_id(); b.st = st;
    if (threadIdx.x == 0) (void)xb_add(&bar[XB_XCNT(b.x)], 1u);
    return b;
}
__device__ __forceinline__ void xcd_barrier_complete(unsigned* bar, unsigned x, unsigned& nloc, unsigned& nx) {
    const unsigned G = gridDim.x * gridDim.y * gridDim.z;
    unsigned sum, cnt, mine, sp = 0u;
    for (;;) {
        sum = 0u; cnt = 0u; mine = 0u;
#pragma unroll
        for (unsigned j = 0; j < 16; ++j) { const unsigned c = xb_ld(&bar[XB_XCNT(j)]); sum += c; cnt += (c > 0u) ? 1u : 0u; mine = (j == x) ? c : mine; }
        if (sum == G) break;
        __builtin_amdgcn_s_sleep(1);
        if ((++sp & 255u) == 0u) { if (xb_ld(&bar[XB_TMO])) break; if (sp > XB_SPIN_CAP) { atomicAdd(&bar[XB_TMO], 1u); break; } }
    }
    nloc = mine > 0u ? mine : 1u; nx = cnt > 0u ? cnt : 1u;
}

__device__ __forceinline__ void xcd_barrier(const XcdBarrier& b) {
    asm volatile("s_waitcnt vmcnt(0)" ::: "memory");
    __syncthreads();
    if (threadIdx.x == 0) {
        unsigned* bar = b.bar;
        __builtin_amdgcn_s_waitcnt(0);
        unsigned nloc = b.st[0], nx = b.st[1];
        if (nloc == 0u) { xcd_barrier_complete(bar, b.x, nloc, nx); b.st[0] = nloc; b.st[1] = nx; }
        const unsigned old = xb_add(&bar[XB_XSUB(b.x)], 1u);
        const unsigned gen = old / nloc;
        if (old + 1u == (gen + 1u) * nloc) {
            __builtin_amdgcn_fence(__ATOMIC_RELEASE, "agent");
            asm volatile("s_waitcnt vmcnt(0)" ::: "memory");
            const unsigned og = xb_add(&bar[XB_TOP], 1u);
            const unsigned tg = og / nx;
            if (og + 1u == (tg + 1u) * nx) xb_add(&bar[XB_TOPGEN], 1u);
            else XB_SPIN(xb_ld(&bar[XB_TOPGEN]) == tg, bar);
            __builtin_amdgcn_fence(__ATOMIC_ACQUIRE, "agent");
            xb_add(&bar[XB_XGEN(b.x)], 1u);
            asm volatile("s_waitcnt vmcnt(0)" ::: "memory");
        } else {
            XB_SPIN(xb_ld(&bar[XB_XGEN(b.x)]) == gen, bar);
            __builtin_amdgcn_fence(__ATOMIC_ACQUIRE, "agent");
            asm volatile("s_waitcnt vmcnt(0)" ::: "memory");
        }
    }
    __syncthreads();
}
struct Frame {
    LAS unsigned char* lds;
    volatile LAS unsigned* MISC;
    gu32* ctl;
    int tid, lane, wave;
    int vcu, G;
};
__device__ __forceinline__ float wave_sum(float v) {
#pragma unroll
    for (int o = 1; o < 64; o <<= 1) v += __shfl_xor(v, o);
    return v;
}
__device__ __forceinline__ float bf2f(bf16 u) { return __uint_as_float((unsigned)u << 16); }
__device__ __forceinline__ float sigmoidf_(float x) { return 1.f / (1.f + __expf(-x)); }
__device__ __forceinline__ float siluf_(float x) { return x / (1.f + __expf(-x)); }

__device__ __forceinline__ void p0_transpose_item(const float* W, int ldw, int c0, bf16* WT, int ldt, int row_off, int nblk, LAS float* scr, int item, int lane) {
    const int kb = item / nblk, nb = item % nblk, k0 = 64 * kb, n0 = 32 * nb;
#pragma unroll 8
    for (int i = 0; i < 32; ++i) { const int kk = 2 * i + (lane >> 5); scr[kk * 33 + (lane & 31)] = W[(size_t)(k0 + kk) * ldw + c0 + n0 + (lane & 31)]; }
    LDS_WAIT(); asm volatile("" ::: "memory");
    const int c = lane & 7;
#pragma unroll
    for (int j = 0; j < 4; ++j) { const int n = (lane >> 3) + 8 * j; const LAS float* s = scr + (8 * c) * 33 + n;
        v4u o; o.x = pk2(s[0 * 33], s[1 * 33]); o.y = pk2(s[2 * 33], s[3 * 33]); o.z = pk2(s[4 * 33], s[5 * 33]); o.w = pk2(s[6 * 33], s[7 * 33]);
        *(GAS v4u*)(WT + (size_t)(row_off + n0 + n) * ldt + k0 + 8 * c) = o; }
    LDS_WAIT(); asm volatile("" ::: "memory");
}
struct Args { const float* in[28]; float* out; unsigned char* ws; int ph_lo, ph_hi, li, pad; };
enum { I_X = 0, I_PRE, I_POST, I_ABWIN, I_ABWOUT, I_CONVW, I_CONVB, I_RGWA, I_RGBA, I_RGWX, I_RGBX, I_LAM, I_HGLB, I_HGNORM, I_MU, I_RWWIN, I_RWWOUT,
       I_W0, I_W1, I_W2, I_A0, I_A1, I_A2, I_KK, I_KA, I_RK, I_LNW, I_LNB };

__device__ __forceinline__ void rms_row_to_bf16(int lane, const float* xrow, const float* gain, bf16* orow) {
    const GAS f32x4* xr = (const GAS f32x4*)xrow + lane; const GAS f32x4* gr = (const GAS f32x4*)gain + lane;
    f32x4 v[4]; float s = 0.f;
#pragma unroll
    for (int j = 0; j < 4; ++j) { v[j] = xr[64 * j]; s += (v[j].x * v[j].x + v[j].y * v[j].y) + (v[j].z * v[j].z + v[j].w * v[j].w); }
    const float rstd = 1.f / sqrtf(wave_sum(s) * (1.f / D) + RMS_EPS);
    GAS unsigned long long* o8 = (GAS unsigned long long*)orow + lane;
#pragma unroll
    for (int j = 0; j < 4; ++j) { const f32x4 g = gr[64 * j];
        o8[64 * j] = (unsigned long long)pk2(v[j].x * rstd * g.x, v[j].y * rstd * g.y) | ((unsigned long long)pk2(v[j].z * rstd * g.z, v[j].w * rstd * g.w) << 32); }
}

__device__ __forceinline__ void p0_prologue(Frame& F, const Args& a) {
    LAS float* scr = (LAS float*)(F.lds + RING_OFF + F.wave * 16384);
    const int gw = F.vcu * NWAVES + F.wave, NGW = F.G * NWAVES;
    bf16* WIN0 = (bf16*)(a.ws + WS_WIN0); bf16* WOUT0 = (bf16*)(a.ws + WS_WOUT0); bf16* WIN1 = (bf16*)(a.ws + WS_WIN1); bf16* WOUT1 = (bf16*)(a.ws + WS_WOUT1);
    constexpr int I_BLK = 16 * 32;
    constexpr int N0 = 6 * I_BLK, N1 = N0 + 32 * 32, N2 = N1 + 4 * I_BLK, N3 = N2 + 32, N4 = N3 + 32, N5 = N4 + I_BLK;
    for (int it = gw; it < N5; it += NGW) {
        if (it < N0) { const int sb = it / I_BLK, r = it % I_BLK; const int db = (sb == 0) ? 0 : (sb == 1) ? 4 : (sb == 2) ? 1 : (sb == 3) ? 2 : (sb == 4) ? 3 : 5;
            p0_transpose_item(a.in[I_ABWIN], NPROJ, sb * 1024, WIN0, 1024, db * 1024, 32, scr, r, F.lane); }
        else if (it < N1) p0_transpose_item(a.in[I_ABWOUT], 1024, 0, WOUT0, 2048, 0, 32, scr, it - N0, F.lane);
        else if (it < N2) { const int p = (it - N1) / I_BLK, r = (it - N1) % I_BLK; p0_transpose_item(a.in[I_RWWIN] + (size_t)p * 1024 * 1024, 1024, 0, WIN1, 1024, p * 1024, 32, scr, r, F.lane); }
        else if (it < N3) p0_transpose_item(a.in[I_W1], 64, 0, WIN1, 1024, 4096, 2, scr, it - N2, F.lane);
        else if (it < N4) p0_transpose_item(a.in[I_A1], 64, 0, WIN1, 1024, 4352, 2, scr, it - N3, F.lane);
        else p0_transpose_item(a.in[I_RWWOUT], 1024, 0, WOUT1, 1024, 0, 32, scr, it - N4, F.lane);
    }
    { const int gt = gw * 64 + F.lane, NGT = NGW * 64; const v4u z = {0u, 0u, 0u, 0u};
      for (int e = gt; e < 2 * 192 * 128; e += NGT) { const int blk = e / (192 * 128), r = e % (192 * 128);
          *(GAS v4u*)(WIN1 + (size_t)(blk ? 4416 : 4160) * 1024 + (size_t)r * 8) = z; } }
    bf16* U0 = (bf16*)(a.ws + WS_U0);
    for (int m = gw; m < M; m += NGW) rms_row_to_bf16(F.lane, a.in[I_X] + (size_t)m * D, a.in[I_PRE], U0 + (size_t)m * D);
}

__device__ __forceinline__ void rg_naive(Frame& F, const Args& a, int item) {
    const int b = item >> 4, n = item & 15, j = F.lane, c = n * 64 + j;
    LAS float* xs = (LAS float*)(F.lds); LAS float* was = xs + 64; LAS float* wxs = was + 4096;
    for (int i = 0; i < 64; ++i) { was[i * 64 + j] = a.in[I_RGWA][(size_t)(n * 64 + i) * 64 + j]; wxs[i * 64 + j] = a.in[I_RGWX][(size_t)(n * 64 + i) * 64 + j]; }
    const float cw0 = a.in[I_CONVW][c], cw1 = a.in[I_CONVW][1024 + c], cw2 = a.in[I_CONVW][2048 + c], cw3 = a.in[I_CONVW][3072 + c], cb = a.in[I_CONVB][c];
    const float ba = a.in[I_RGBA][c], bx = a.in[I_RGBX][c];
    const float sp = log1pf(expf(-a.in[I_LAM][c]));
    bf16* P = (bf16*)(a.ws + WS_BIG) + (size_t)b * T * NPROJ;
    float xm1 = 0.f, xm2 = 0.f, xm3 = 0.f, h = 0.f;
    for (int t0 = 0; t0 < T; t0 += 8) {
        float xin[8], gg[8];
#pragma unroll
        for (int q = 0; q < 8; ++q) { xin[q] = bf2f(P[(size_t)(t0 + q) * NPROJ + C_RGX + c]); gg[q] = bf2f(P[(size_t)(t0 + q) * NPROJ + C_RGG + c]); }
#pragma unroll 1
        for (int q = 0; q < 8; ++q) {
            float xq = xin[0], gq = gg[0];
#pragma unroll
            for (int z = 1; z < 8; ++z) if (q == z) { xq = xin[z]; gq = gg[z]; }
            const float xc = cw0 * xm3 + cw1 * xm2 + cw2 * xm1 + cw3 * xq + cb;
            xm3 = xm2; xm2 = xm1; xm1 = xq;
            asm volatile("" ::: "memory");
            xs[j] = xc;
            asm volatile("s_waitcnt lgkmcnt(0)" ::: "memory");
            float gr = ba, gi = bx;
#pragma unroll
            for (int i = 0; i < 64; ++i) { const float xi = xs[i]; gr += xi * was[i * 64 + j]; gi += xi * wxs[i * 64 + j]; }
            asm volatile("s_waitcnt lgkmcnt(0)" ::: "memory");
            const float gate_r = sigmoidf_(gr), gate_i = sigmoidf_(gi);
            const float log_a = -8.0f * gate_r * sp;
            const float av = expf(log_a), mult = sqrtf(-expm1f(2.0f * log_a));
            h = av * h + mult * (gate_i * xc);
            P[(size_t)(t0 + q) * NPROJ + C_RGG + c] = (bf16)f2bf(h * siluf_(gq));
        }
    }
}

__device__ __forceinline__ void hg_naive(Frame& F, const Args& a, int item) {
    const int b = item >> 3, hh = item & 7, tid = F.tid, v = tid & 127, dg = __builtin_amdgcn_readfirstlane(tid >> 7);
    LAS float* qs = (LAS float*)(F.lds); LAS float* fs = qs + 2048; LAS float* ks = fs + 2048; LAS float* vs = ks + 2048; LAS float* po = vs + 2048;
    bf16* P = (bf16*)(a.ws + WS_BIG) + (size_t)b * T * NPROJ;
    float lb; { const int c = hh * 128 + v; const float l0 = a.in[I_HGLB][c], l1 = a.in[I_HGLB][1024 + c], l2 = a.in[I_HGLB][2048 + c];
        const float mx = fmaxf(l0, fmaxf(l1, l2)); const float e0 = expf(l0 - mx), e1 = expf(l1 - mx), e2 = expf(l2 - mx); lb = e1 / (e0 + e1 + e2); }
    float s[32];
#pragma unroll
    for (int i = 0; i < 32; ++i) s[i] = 0.f;
    for (int t0 = 0; t0 < T; t0 += 16) {
#pragma unroll
        for (int k = 0; k < 4; ++k) { const int t = (tid >> 7) + 4 * k; const bf16* row = P + (size_t)(t0 + t) * NPROJ + hh * 128 + v;
            const float q = bf2f(row[C_HGQ]), fr = bf2f(row[C_HGF]), vi = bf2f(row[C_HGI]);
            const float f = lb + (1.f - lb) * sigmoidf_(fr);
            qs[t * 128 + v] = siluf_(q); fs[t * 128 + v] = f; ks[t * 128 + v] = 1.f - f; vs[t * 128 + v] = vi; }
        __syncthreads();
#pragma unroll 1
        for (int t = 0; t < 16; ++t) {
            float acc = 0.f; const float vv = vs[t * 128 + v];
#pragma unroll
            for (int i = 0; i < 32; ++i) { const int d = dg * 32 + i; s[i] = fs[t * 128 + d] * s[i] + ks[t * 128 + d] * vv; acc += qs[t * 128 + d] * s[i]; }
            po[(t * 4 + dg) * 128 + v] = acc;
        }
        __syncthreads();
#pragma unroll
        for (int tt = 0; tt < 2; ++tt) { const int t = F.wave * 2 + tt;
            float o0 = 0.f, o1 = 0.f;
#pragma unroll
            for (int g = 0; g < 4; ++g) { o0 += po[(t * 4 + g) * 128 + F.lane]; o1 += po[(t * 4 + g) * 128 + 64 + F.lane]; }
            const float ss = wave_sum(o0 * o0 + o1 * o1); const float rstd = 1.f / sqrtf(ss * (1.f / 128.f) + RMS_EPS);
            bf16* row = P + (size_t)(t0 + t) * NPROJ + C_HGG + hh * 128;
            const float g0 = bf2f(row[F.lane]), g1 = bf2f(row[64 + F.lane]);
            row[F.lane] = (bf16)f2bf(o0 * rstd * a.in[I_HGNORM][F.lane] * siluf_(g0));
            row[64 + F.lane] = (bf16)f2bf(o1 * rstd * a.in[I_HGNORM][64 + F.lane] * siluf_(g1)); }
        __syncthreads();
    }
}

__device__ __forceinline__ void rw_naive(Frame& F, const Args& a, int item) {
    const int b = item >> 4, hh = item & 15, j = F.lane, c = hh * 64 + j;
    LAS float* w2s = (LAS float*)(F.lds); LAS float* a2s = w2s + 4096; LAS float* vec = a2s + 4096;
    for (int i = 0; i < 64; ++i) { w2s[i * 64 + j] = a.in[I_W2][(size_t)i * 1024 + c]; a2s[i * 64 + j] = a.in[I_A2][(size_t)i * 1024 + c]; }
    const float w0c = a.in[I_W0][c], a0c = a.in[I_A0][c], kkc = a.in[I_KK][c], kac = a.in[I_KA][c], rkc = a.in[I_RK][c], lnw = a.in[I_LNW][c], lnb = a.in[I_LNB][c];
    const bf16* Rr = (const bf16*)(a.ws + WS_BIG + 4 * RSZ) + (size_t)b * T * 1024 + c;
    const bf16* Rk = (const bf16*)(a.ws + WS_BIG + 5 * RSZ) + (size_t)b * T * 1024 + c;
    const bf16* Rv = (const bf16*)(a.ws + WS_BIG + 0 * RSZ) + (size_t)b * T * 1024 + c;
    const bf16* Rg = (const bf16*)(a.ws + WS_BIG + 1 * RSZ) + (size_t)b * T * 1024 + c;
    bf16* Z = (bf16*)(a.ws + WS_BIG + 2 * RSZ) + (size_t)b * T * 1024 + c;
    const bf16* D1w = (const bf16*)(a.ws + WS_U0) + (size_t)b * T * 64 + j;
    const bf16* D1a = (const bf16*)(a.ws + WS_U0) + (size_t)M * 64 + (size_t)b * T * 64 + j;
    float S[64];
#pragma unroll
    for (int i = 0; i < 64; ++i) S[i] = 0.f;
    asm volatile("s_waitcnt lgkmcnt(0)" ::: "memory");
    for (int t0 = 0; t0 < T; t0 += 8) {
        float pr[8], pk[8], pv[8], pg[8], pdw[8], pda[8];
#pragma unroll
        for (int q = 0; q < 8; ++q) { const size_t o = (size_t)(t0 + q) * 1024; pr[q] = bf2f(Rr[o]); pk[q] = bf2f(Rk[o]); pv[q] = bf2f(Rv[o]); pg[q] = bf2f(Rg[o]);
            pdw[q] = bf2f(D1w[(size_t)(t0 + q) * 64]); pda[q] = bf2f(D1a[(size_t)(t0 + q) * 64]); }
#pragma unroll 1
        for (int q = 0; q < 8; ++q) {
            float rr, kv, vv, gv, dw, da;
            rr = pr[0]; kv = pk[0]; vv = pv[0]; gv = pg[0]; dw = pdw[0]; da = pda[0];
#pragma unroll
            for (int z = 1; z < 8; ++z) if (q == z) { rr = pr[z]; kv = pk[z]; vv = pv[z]; gv = pg[z]; dw = pdw[z]; da = pda[z]; }
            asm volatile("" ::: "memory");
            vec[5 * 64 + j] = dw; vec[6 * 64 + j] = da;
            asm volatile("s_waitcnt lgkmcnt(0)" ::: "memory");
            float zw = w0c, za = a0c;
#pragma unroll 16
            for (int i = 0; i < 64; ++i) { zw += vec[5 * 64 + i] * w2s[i * 64 + j]; za += vec[6 * 64 + i] * a2s[i * 64 + j]; }
            const float w_log = -log1pf(expf(-zw)) - 0.5f;
            const float wdec = expf(-expf(w_log));
            const float iclr = sigmoidf_(za);
            float kkv = kv * kkc; const float nrm = sqrtf(wave_sum(kkv * kkv)); kkv = kkv / fmaxf(nrm, 1e-12f);
            const float k2 = kv * (1.f + (iclr - 1.f) * kac);
            const float bonus = wave_sum(rr * k2 * rkc);
            asm volatile("s_waitcnt lgkmcnt(0)" ::: "memory");
            vec[0 * 64 + j] = wdec; vec[1 * 64 + j] = -kkv; vec[2 * 64 + j] = kkv * iclr; vec[3 * 64 + j] = k2; vec[4 * 64 + j] = rr;
            asm volatile("s_waitcnt lgkmcnt(0)" ::: "memory");
            float sa = 0.f;
#pragma unroll
            for (int k = 0; k < 64; ++k) sa += S[k] * vec[1 * 64 + k];
            float y = 0.f;
#pragma unroll
            for (int k = 0; k < 64; ++k) { S[k] = S[k] * vec[0 * 64 + k] + sa * vec[2 * 64 + k] + vv * vec[3 * 64 + k]; y += S[k] * vec[4 * 64 + k]; }
            asm volatile("s_waitcnt lgkmcnt(0)" ::: "memory");
            const float mean = wave_sum(y) * (1.f / 64.f); const float dy = y - mean; const float var = wave_sum(dy * dy) * (1.f / 64.f);
            float yn = dy * (1.f / sqrtf(var + 64e-5f)) * lnw + lnb;
            yn += bonus * vv;
            Z[(size_t)(t0 + q) * 1024] = (bf16)f2bf(yn * siluf_(gv));
        }
    }
}
constexpr size_t WS_RGA = WS_U0, WS_RGB = WS_U0 + 1 * MiB, WS_HIN = WS_U0 + 2 * MiB, WS_HGD = WS_U0 + 3 * MiB;
constexpr size_t WS_RGW = WS_SMALL + 64 * 1024;
typedef short bf16x8s __attribute__((ext_vector_type(8)));
#define MFMA16(a, b, c) __builtin_amdgcn_mfma_f32_16x16x32_bf16((a), (b), (c), 0, 0, 0)

__device__ __forceinline__ void rg_prep_weights(Frame& F, const Args& a) {
    bf16* RGW = (bf16*)(a.ws + WS_RGW);
    const int gt = (F.vcu * NWAVES + F.wave) * 64 + F.lane, NGT = F.G * NWAVES * 64;
    for (int e = gt; e < 2 * 16 * 64 * 64; e += NGT) { const int gate = e >> 16, n = (e >> 12) & 15, j = (e >> 6) & 63, i = e & 63;
        const float* W = gate ? a.in[I_RGWX] : a.in[I_RGWA]; RGW[e] = (bf16)f2bf(W[(size_t)(n * 64 + i) * 64 + j]); }
}

template <int MODE>
__device__ __forceinline__ void rg_item(Frame& F, const Args& a, int b, int ci, int n) {
    const int lane = F.lane, c16 = lane & 15, g = lane >> 4;
    LAS bf16* XC = (LAS bf16*)(F.lds + F.wave * 9216);
    bf16* P = (bf16*)(a.ws + WS_BIG) + ((size_t)b * T + (size_t)ci * 64) * NPROJ;
    {
        const int c = n * 64 + lane;
        const float cw0 = a.in[I_CONVW][c], cw1 = a.in[I_CONVW][1024 + c], cw2 = a.in[I_CONVW][2048 + c], cw3 = a.in[I_CONVW][3072 + c], cb = a.in[I_CONVB][c];
        float xm3 = 0.f, xm2 = 0.f, xm1 = 0.f;
        if (ci > 0) { xm3 = bf2f(*(P - 3 * (size_t)NPROJ + C_RGX + c)); xm2 = bf2f(*(P - 2 * (size_t)NPROJ + C_RGX + c)); xm1 = bf2f(*(P - (size_t)NPROJ + C_RGX + c)); }
#pragma unroll 16
        for (int t = 0; t < 64; ++t) { const float x = bf2f(P[(size_t)t * NPROJ + C_RGX + c]);
            const float xc = cw0 * xm3 + cw1 * xm2 + cw2 * xm1 + cw3 * x + cb; xm3 = xm2; xm2 = xm1; xm1 = x;
            XC[t * 72 + lane] = (bf16)f2bf(xc); }
    }
    asm volatile("s_waitcnt lgkmcnt(0)" ::: "memory");
    const bf16* RGW = (const bf16*)(a.ws + WS_RGW);
    bf16x8s br[4][2], bi[4][2]; float ba[4], bx[4], sp8[4];
#pragma unroll
    for (int nt = 0; nt < 4; ++nt) { const int c = n * 64 + nt * 16 + c16;
#pragma unroll
        for (int kk = 0; kk < 2; ++kk) { br[nt][kk] = *(const bf16x8s*)(RGW + ((size_t)(n * 64 + nt * 16 + c16)) * 64 + kk * 32 + 8 * g);
                                         bi[nt][kk] = *(const bf16x8s*)(RGW + ((size_t)((16 + n) * 64 + nt * 16 + c16)) * 64 + kk * 32 + 8 * g); }
        ba[nt] = a.in[I_RGBA][c]; bx[nt] = a.in[I_RGBX][c]; sp8[nt] = 8.0f * log1pf(expf(-a.in[I_LAM][c])); }
    float Ac[4], Bc[4];
#pragma unroll
    for (int nt = 0; nt < 4; ++nt) { Ac[nt] = 1.f; Bc[nt] = 0.f;
        if (MODE == 1) Bc[nt] = ((const float*)(a.ws + WS_HIN))[((size_t)b * 128 + ci) * 1024 + n * 64 + nt * 16 + c16]; }
#pragma unroll 1
    for (int m = 0; m < 4; ++m) {
        bf16x8s af[2];
#pragma unroll
        for (int kk = 0; kk < 2; ++kk) af[kk] = *(const LAS bf16x8s*)(XC + (16 * m + c16) * 72 + kk * 32 + 8 * g);
#pragma unroll
        for (int nt = 0; nt < 4; ++nt) {
            f32x4 ar = {0.f, 0.f, 0.f, 0.f}, ai = {0.f, 0.f, 0.f, 0.f};
#pragma unroll
            for (int kk = 0; kk < 2; ++kk) { ar = MFMA16(af[kk], br[nt][kk], ar); ai = MFMA16(af[kk], bi[nt][kk], ai); }
            float Ainc[4], Binc[4];
#pragma unroll
            for (int i = 0; i < 4; ++i) { const int t = 16 * m + 4 * g + i;
                const float gate_r = sigmoidf_(ar[i] + ba[nt]), gate_i = sigmoidf_(ai[i] + bx[nt]);
                const float log_a = -gate_r * sp8[nt]; const float av = __expf(log_a), mult = sqrtf(-expm1f(2.0f * log_a));
                const float xc = bf2f(XC[t * 72 + nt * 16 + c16]); const float bv = mult * (gate_i * xc);
                if (i == 0) { Ainc[0] = av; Binc[0] = bv; } else { Ainc[i] = av * Ainc[i - 1]; Binc[i] = av * Binc[i - 1] + bv; } }
            const float A4 = Ainc[3], B4 = Binc[3];
            float Ap = 1.f, Bp = 0.f, At = 1.f, Bt = 0.f;
#pragma unroll
            for (int gp = 0; gp < 4; ++gp) { const float Ag = __shfl(A4, c16 + 16 * gp), Bg = __shfl(B4, c16 + 16 * gp);
                if (gp < g) { Bp = Ag * Bp + Bg; Ap = Ag * Ap; }
                Bt = Ag * Bt + Bg; At = Ag * At; }
            if (MODE == 1) {
                const float hg = Ap * Bc[nt] + Bp;
#pragma unroll
                for (int i = 0; i < 4; ++i) { const int t = 16 * m + 4 * g + i; const float h = Ainc[i] * hg + Binc[i];
                    bf16* gp_ = P + (size_t)t * NPROJ + C_RGG + n * 64 + nt * 16 + c16; *gp_ = (bf16)f2bf(h * siluf_(bf2f(*gp_))); }
                Bc[nt] = At * Bc[nt] + Bt;
            } else { Bc[nt] = At * Bc[nt] + Bt; Ac[nt] = At * Ac[nt]; }
        }
    }
    if (MODE == 0 && g == 0) {
#pragma unroll
        for (int nt = 0; nt < 4; ++nt) { const size_t o = ((size_t)b * 128 + ci) * 1024 + n * 64 + nt * 16 + c16;
            ((float*)(a.ws + WS_RGA))[o] = Ac[nt]; ((float*)(a.ws + WS_RGB))[o] = Bc[nt]; }
    }
    asm volatile("s_waitcnt lgkmcnt(0)" ::: "memory");
}
template <int MODE>
__device__ __forceinline__ void rg_phase(Frame& F, const Args& a) {
    for (int it = blockIdx.x; it < 512; it += F.G) { const int b = it >> 8, ci = (it >> 1) & 127, n = (it & 1) * 8 + F.wave; rg_item<MODE>(F, a, b, ci, n); }
}
__device__ __forceinline__ void rg_scan(Frame& F, const Args& a) {
    const int gt = (F.vcu * NWAVES + F.wave) * 64 + F.lane;
    if (gt < 2048) { const int b = gt >> 10, c = gt & 1023; float h = 0.f;
        const float* A = (const float*)(a.ws + WS_RGA) + (size_t)b * 128 * 1024 + c; const float* B = (const float*)(a.ws + WS_RGB) + (size_t)b * 128 * 1024 + c;
        float* H = (float*)(a.ws + WS_HIN) + (size_t)b * 128 * 1024 + c;
#pragma unroll 8
        for (int ci = 0; ci < 128; ++ci) { H[(size_t)ci * 1024] = h; h = A[(size_t)ci * 1024] * h + B[(size_t)ci * 1024]; } }
}
typedef unsigned u32x2s __attribute__((ext_vector_type(2)));
__device__ __forceinline__ void hg_lb8(const Args& a, int hh, int dq, float (&lb)[8]) {
#pragma unroll
    for (int e = 0; e < 8; ++e) { const int c = hh * 128 + dq * 8 + e; const float l0 = a.in[I_HGLB][c], l1 = a.in[I_HGLB][1024 + c], l2 = a.in[I_HGLB][2048 + c];
        const float mx = fmaxf(l0, fmaxf(l1, l2)); const float e0 = __expf(l0 - mx), e1 = __expf(l1 - mx), e2 = __expf(l2 - mx); lb[e] = e1 / (e0 + e1 + e2); }
}
__device__ __forceinline__ void hg_logf(Frame& F, const bf16* Prow0, int hh, const float (&lb)[8], LAS float* G) {
    const int tid = F.tid, dq = tid & 15;
#pragma unroll
    for (int rep = 0; rep < 2; ++rep) { const int t = (tid >> 4) + 32 * rep;
        const v4u raw = *(const GAS v4u*)(Prow0 + (size_t)t * NPROJ + C_HGF + hh * 128 + dq * 8);
        const unsigned w[4] = {raw.x, raw.y, raw.z, raw.w}; float o[8];
#pragma unroll
        for (int e = 0; e < 8; ++e) { const float fr = __uint_as_float((e & 1) ? (w[e >> 1] & 0xffff0000u) : (w[e >> 1] << 16));
            o[e] = __logf(lb[e] + (1.f - lb[e]) * sigmoidf_(fr)); }
        *(LAS f32x4*)(G + t * 128 + dq * 8) = (f32x4){o[0], o[1], o[2], o[3]}; *(LAS f32x4*)(G + t * 128 + dq * 8 + 4) = (f32x4){o[4], o[5], o[6], o[7]}; }
}
__device__ __forceinline__ void hg_cumsum(Frame& F, LAS float* G) {
    if (F.tid < 128) { float acc = 0.f;
#pragma unroll 16
        for (int s = 0; s < 64; ++s) { acc += G[s * 128 + F.tid]; G[s * 128 + F.tid] = acc; } }
}
__device__ __forceinline__ void hg_vt(Frame& F, const bf16* Prow0, int hh, LAS bf16* VT, int tid0, int nthr) {
    for (int e = tid0; e < 1024; e += nthr) { const int s = e >> 4, vq = e & 15;
        const v4u raw = *(const GAS v4u*)(Prow0 + (size_t)s * NPROJ + C_HGI + hh * 128 + vq * 8);
        const unsigned w[4] = {raw.x, raw.y, raw.z, raw.w};
#pragma unroll
        for (int k = 0; k < 8; ++k) VT[(vq * 8 + k) * 72 + s] = (bf16)((k & 1) ? (w[k >> 1] >> 16) : (w[k >> 1] & 0xffffu)); }
}

__device__ __forceinline__ void hg_phase_a(Frame& F, const Args& a) {
    LAS float* G = (LAS float*)(F.lds); LAS bf16* KT = (LAS bf16*)(F.lds + 32768); LAS bf16* VT = (LAS bf16*)(F.lds + 32768 + 18432);
    bf16* ST = (bf16*)a.out; float* HGD = (float*)(a.ws + WS_HGD);
    const int tid = F.tid, lane = F.lane, c16 = lane & 15, g = lane >> 4, w = F.wave;
    for (int it = blockIdx.x; it < 2048; it += F.G) {
        const int bh = it >> 7, ci = it & 127, b = bh >> 3, hh = bh & 7;
        const bf16* Prow0 = (const bf16*)(a.ws + WS_BIG) + ((size_t)b * T + (size_t)ci * 64) * NPROJ;
        float lb[8]; hg_lb8(a, hh, tid & 15, lb);
        hg_logf(F, Prow0, hh, lb, G);
        __syncthreads();
        hg_cumsum(F, G);
        if (tid >= 128) hg_vt(F, Prow0, hh, VT, tid - 128, 384);
        __syncthreads();
        {
            const int d = tid & 127, sg = tid >> 7; const float gend = G[63 * 128 + d];
            float prev = (sg == 0) ? 0.f : G[(sg * 16 - 1) * 128 + d]; unsigned pk[8];
#pragma unroll
            for (int i = 0; i < 16; ++i) { const float gv = G[(sg * 16 + i) * 128 + d]; const float k = 1.f - __expf(gv - prev); prev = gv;
                const unsigned hb = f2bf(k * __expf(gend - gv)); if (i & 1) pk[i >> 1] |= hb << 16; else pk[i >> 1] = hb; }
            *(LAS v4u*)(KT + d * 72 + sg * 16) = (v4u){pk[0], pk[1], pk[2], pk[3]}; *(LAS v4u*)(KT + d * 72 + sg * 16 + 8) = (v4u){pk[4], pk[5], pk[6], pk[7]};
            if (sg == 0) HGD[(size_t)it * 128 + d] = __expf(gend);
        }
        __syncthreads();
        {
            bf16x8s ka[2];
#pragma unroll
            for (int kk = 0; kk < 2; ++kk) ka[kk] = *(const LAS bf16x8s*)(KT + (16 * w + c16) * 72 + kk * 32 + 8 * g);
#pragma unroll
            for (int nt = 0; nt < 8; ++nt) { f32x4 acc = {0.f, 0.f, 0.f, 0.f};
#pragma unroll
                for (int kk = 0; kk < 2; ++kk) { const bf16x8s vb = *(const LAS bf16x8s*)(VT + (nt * 16 + c16) * 72 + kk * 32 + 8 * g); acc = MFMA16(ka[kk], vb, acc); }
                u32x2s o; o.x = pk2(acc[0], acc[1]); o.y = pk2(acc[2], acc[3]);
                *(GAS u32x2s*)(ST + (size_t)it * 16384 + (size_t)(nt * 16 + c16) * 128 + 16 * w + 4 * g) = o; }
        }
        __syncthreads();
    }
}
__device__ __forceinline__ void hg_phase_b(Frame& F, const Args& a) {
    bf16* ST = (bf16*)a.out; const float* HGD = (const float*)(a.ws + WS_HGD);
    const int gt0 = (F.vcu * NWAVES + F.wave) * 64 + F.lane, NGT = F.G * NWAVES * 64;
    for (int gt = gt0; gt < 16 * 8192; gt += NGT) { const int bh = gt >> 13, e2 = gt & 8191, v = e2 >> 6, d = (e2 & 63) * 2;
        unsigned* p = (unsigned*)(ST + (size_t)bh * 128 * 16384 + (size_t)v * 128 + d); const float* dp = HGD + (size_t)bh * 128 * 128 + d;
        float s0 = 0.f, s1 = 0.f;
#pragma unroll 8
        for (int ci = 0; ci < 128; ++ci) { const unsigned u = p[(size_t)ci * 8192]; const float d0 = dp[ci * 128], d1 = dp[ci * 128 + 1];
            p[(size_t)ci * 8192] = pk2(s0, s1);
            s0 = d0 * s0 + __uint_as_float(u << 16); s1 = d1 * s1 + __uint_as_float(u & 0xffff0000u); } }
}
__device__ __forceinline__ void hg_phase_c(Frame& F, const Args& a) {
    LAS float* G = (LAS float*)(F.lds);
    LAS bf16* QT = (LAS bf16*)(F.lds + 32768);
    LAS bf16* KT2 = (LAS bf16*)(F.lds + 32768 + 17408);
    LAS bf16* QG = (LAS bf16*)(F.lds + 32768 + 2 * 17408);
    LAS bf16* VT = (LAS bf16*)(F.lds + 32768 + 3 * 17408);
    LAS bf16* PM = (LAS bf16*)(F.lds + 32768 + 3 * 17408 + 18432);
    LAS float* SS = (LAS float*)(F.lds + 32768 + 3 * 17408 + 18432 + 9216);
    const bf16* ST = (const bf16*)a.out;
    const int tid = F.tid, lane = F.lane, c16 = lane & 15, g = lane >> 4, w = F.wave;
    for (int it = blockIdx.x; it < 2048; it += F.G) {
        const int bh = it >> 7, ci = it & 127, b = bh >> 3, hh = bh & 7;
        bf16* Prow0 = (bf16*)(a.ws + WS_BIG) + ((size_t)b * T + (size_t)ci * 64) * NPROJ;
        float lb[8]; hg_lb8(a, hh, tid & 15, lb);
        hg_logf(F, Prow0, hh, lb, G);
        __syncthreads();
        hg_cumsum(F, G);
        if (tid >= 128) hg_vt(F, Prow0, hh, VT, tid - 128, 384);
        __syncthreads();
        {
            const int dq = tid & 15;
#pragma unroll
            for (int rep = 0; rep < 2; ++rep) { const int t = (tid >> 4) + 32 * rep;
                const v4u rq = *(const GAS v4u*)(Prow0 + (size_t)t * NPROJ + C_HGQ + hh * 128 + dq * 8);
                const v4u rf = *(const GAS v4u*)(Prow0 + (size_t)t * NPROJ + C_HGF + hh * 128 + dq * 8);
                const unsigned wq[4] = {rq.x, rq.y, rq.z, rq.w}, wf[4] = {rf.x, rf.y, rf.z, rf.w};
                unsigned oq[4], ok[4], og[4];
#pragma unroll
                for (int e = 0; e < 8; ++e) { const float qv = __uint_as_float((e & 1) ? (wq[e >> 1] & 0xffff0000u) : (wq[e >> 1] << 16));
                    const float fr = __uint_as_float((e & 1) ? (wf[e >> 1] & 0xffff0000u) : (wf[e >> 1] << 16));
                    const float f = lb[e] + (1.f - lb[e]) * sigmoidf_(fr); const float k = 1.f - f; const float qs = siluf_(qv);
                    const float gv = G[t * 128 + dq * 8 + e], gr = G[31 * 128 + dq * 8 + e];
                    const unsigned hq = f2bf(qs * __expf(gv - gr)), hk = f2bf(k * __expf(gr - gv)), hg_ = f2bf(qs * __expf(gv));
                    if (e & 1) { oq[e >> 1] |= hq << 16; ok[e >> 1] |= hk << 16; og[e >> 1] |= hg_ << 16; } else { oq[e >> 1] = hq; ok[e >> 1] = hk; og[e >> 1] = hg_; } }
                *(LAS v4u*)(QT + t * 136 + dq * 8) = (v4u){oq[0], oq[1], oq[2], oq[3]};
                *(LAS v4u*)(KT2 + t * 136 + dq * 8) = (v4u){ok[0], ok[1], ok[2], ok[3]};
                *(LAS v4u*)(QG + t * 136 + dq * 8) = (v4u){og[0], og[1], og[2], og[3]}; }
        }
        __syncthreads();
        {
            const int ms = w >> 1;
#pragma unroll
            for (int q = 0; q < 2; ++q) { const int nt = (w & 1) * 2 + q; f32x4 acc = {0.f, 0.f, 0.f, 0.f};
                if (ms <= nt) {
#pragma unroll
                    for (int kk = 0; kk < 4; ++kk) { const bf16x8s ka = *(const LAS bf16x8s*)(KT2 + (16 * ms + c16) * 136 + kk * 32 + 8 * g);
                        const bf16x8s qb = *(const LAS bf16x8s*)(QT + (16 * nt + c16) * 136 + kk * 32 + 8 * g); acc = MFMA16(ka, qb, acc); } }
                const int t = 16 * nt + c16; float pv[4];
#pragma unroll
                for (int i = 0; i < 4; ++i) { const int s = 16 * ms + 4 * g + i; pv[i] = (s <= t) ? acc[i] : 0.f; }
                u32x2s o; o.x = pk2(pv[0], pv[1]); o.y = pk2(pv[2], pv[3]);
                *(LAS u32x2s*)(PM + t * 72 + 16 * ms + 4 * g) = o; }
        }
        __syncthreads();
        {
            bf16x8s va[2], sa[4];
#pragma unroll
            for (int kk = 0; kk < 2; ++kk) va[kk] = *(const LAS bf16x8s*)(VT + (16 * w + c16) * 72 + kk * 32 + 8 * g);
#pragma unroll
            for (int kk = 0; kk < 4; ++kk) sa[kk] = *(const GAS bf16x8s*)(ST + (size_t)it * 16384 + (size_t)(16 * w + c16) * 128 + kk * 32 + 8 * g);
            f32x4 acc[4];
#pragma unroll
            for (int nt = 0; nt < 4; ++nt) { acc[nt] = (f32x4){0.f, 0.f, 0.f, 0.f};
#pragma unroll
                for (int kk = 0; kk < 2; ++kk) { const bf16x8s pb = *(const LAS bf16x8s*)(PM + (16 * nt + c16) * 72 + kk * 32 + 8 * g); acc[nt] = MFMA16(va[kk], pb, acc[nt]); }
#pragma unroll
                for (int kk = 0; kk < 4; ++kk) { const bf16x8s qb = *(const LAS bf16x8s*)(QG + (16 * nt + c16) * 136 + kk * 32 + 8 * g); acc[nt] = MFMA16(sa[kk], qb, acc[nt]); }
                float p = (acc[nt][0] * acc[nt][0] + acc[nt][1] * acc[nt][1]) + (acc[nt][2] * acc[nt][2] + acc[nt][3] * acc[nt][3]);
                p += __shfl_xor(p, 16); p += __shfl_xor(p, 32);
                if (g == 0) SS[w * 64 + 16 * nt + c16] = p; }
            __syncthreads();
            const f32x4 gn = *(const GAS f32x4*)(a.in[I_HGNORM] + 16 * w + 4 * g);
#pragma unroll
            for (int nt = 0; nt < 4; ++nt) { const int t = 16 * nt + c16; float ss = 0.f;
#pragma unroll
                for (int q = 0; q < 8; ++q) ss += SS[q * 64 + t];
                const float rstd = 1.f / sqrtf(ss * (1.f / 128.f) + RMS_EPS);
                u32x2s* gp_ = (u32x2s*)(Prow0 + (size_t)t * NPROJ + C_HGG + hh * 128 + 16 * w + 4 * g); const u32x2s gr = *gp_;
                const float g0 = __uint_as_float(gr.x << 16), g1 = __uint_as_float(gr.x & 0xffff0000u), g2 = __uint_as_float(gr.y << 16), g3 = __uint_as_float(gr.y & 0xffff0000u);
                u32x2s o; o.x = pk2(acc[nt][0] * rstd * gn[0] * siluf_(g0), acc[nt][1] * rstd * gn[1] * siluf_(g1));
                o.y = pk2(acc[nt][2] * rstd * gn[2] * siluf_(g2), acc[nt][3] * rstd * gn[3] * siluf_(g3)); *gp_ = o; }
        }
        __syncthreads();
    }
}
constexpr size_t WS_W2T = WS_SMALL + 512 * 1024;
constexpr size_t WS_GC = WS_U0 + 8 * MiB;
constexpr int RW_A = 0;
constexpr int RW_B = 18432;
constexpr int RW_C = RW_B + 62464;
constexpr int RW_TD = RW_C + 46080;

__device__ __forceinline__ void rw_prep_weights(Frame& F, const Args& a) {
    bf16* WT = (bf16*)(a.ws + WS_W2T);
    const int gt = (F.vcu * NWAVES + F.wave) * 64 + F.lane, NGT = F.G * NWAVES * 64;
    for (int e = gt; e < 2 * 65536; e += NGT) { const int which = e >> 16, ch = (e >> 6) & 1023, i = e & 63;
        WT[e] = (bf16)f2bf((which ? a.in[I_A2] : a.in[I_W2])[(size_t)i * 1024 + ch]); }
}
__device__ __forceinline__ bf16x8s pack8(const f32x4& lo, const f32x4& hi) {
    v4u p; p.x = pk2(lo[0], lo[1]); p.y = pk2(lo[2], lo[3]); p.z = pk2(hi[0], hi[1]); p.w = pk2(hi[2], hi[3]); return __builtin_bit_cast(bf16x8s, p); }
__device__ __forceinline__ size_t tile_chunk_off(int q) { return (size_t)(q >> 3) * 2048 + (size_t)(q & 7) * 16; }

__device__ __forceinline__ void rw_phase_a(Frame& F, const Args& a) {
    LAS unsigned char* L = F.lds;
    LAS bf16* DW = (LAS bf16*)(L + RW_A); LAS bf16* DA = DW + 4608; LAS bf16* BT = DW; LAS bf16* KT = DA; LAS bf16* XT = DW;
    LAS bf16* RR = (LAS bf16*)(L + RW_B); LAS bf16* KK = RR + 4608; LAS bf16* VV = KK + 4608;
    LAS float* LW = (LAS float*)(L + RW_B + 27648); LAS float* IC = (LAS float*)(L + RW_B + 45056);
    LAS float* MAB = (LAS float*)(L + RW_B); LAS bf16* MABh = (LAS bf16*)(L + RW_B + 17408); LAS bf16* MAK = MABh + 4608; LAS bf16* MRB = MAK + 4608; LAS bf16* MRK = MRB + 4608;
    LAS bf16* VT = (LAS bf16*)(L + RW_C); LAS bf16* AT = VT + 4608; LAS bf16* RT = AT + 4608; LAS bf16* BH = RT + 4608; LAS bf16* KH = BH + 4608;
    LAS bf16* TD = (LAS bf16*)(L + RW_TD);
    const int tid = F.tid, lane = F.lane, c16 = lane & 15, g = lane >> 4, w = F.wave;
    unsigned char* const ws = a.ws;
    const bf16* W2T = (const bf16*)(ws + WS_W2T);
    for (int it = blockIdx.x; it < 4096; it += F.G) {
        const int bh = it >> 7, ci = it & 127, b = bh >> 4, hh = bh & 15;
        const size_t row0 = (size_t)b * T + (size_t)ci * 64;
        unsigned char* rt_ = ws + WS_BIG + 4 * RSZ + (row0 * 1024 + hh * 64) * 2;
        unsigned char* kt_ = ws + WS_BIG + 5 * RSZ + (row0 * 1024 + hh * 64) * 2;
        unsigned char* vt_ = ws + WS_BIG + 0 * RSZ + (row0 * 1024 + hh * 64) * 2;
        unsigned char* yl_ = ws + WS_BIG + 2 * RSZ + (row0 * 1024 + hh * 64) * 2;
        { const int t = tid >> 3, cq = tid & 7;
          const v4u xr = *(const GAS v4u*)(rt_ + (size_t)t * 2048 + cq * 16), xk = *(const GAS v4u*)(kt_ + (size_t)t * 2048 + cq * 16), xv = *(const GAS v4u*)(vt_ + (size_t)t * 2048 + cq * 16);
          const v4u xw = *(const GAS v4u*)(ws + WS_U0 + ((row0 + t) * 64 + cq * 8) * 2), xa = *(const GAS v4u*)(ws + WS_U0 + ((size_t)M * 64 + (row0 + t) * 64 + cq * 8) * 2);
          *(LAS v4u*)(RR + t * 72 + cq * 8) = xr; *(LAS v4u*)(KK + t * 72 + cq * 8) = xk; *(LAS v4u*)(VV + t * 72 + cq * 8) = xv;
          *(LAS v4u*)(DW + t * 72 + cq * 8) = xw; *(LAS v4u*)(DA + t * 72 + cq * 8) = xa;
          const unsigned wv[4] = {xv.x, xv.y, xv.z, xv.w};
#pragma unroll
          for (int k = 0; k < 8; ++k) VT[(cq * 8 + k) * 72 + t] = (bf16)((k & 1) ? (wv[k >> 1] >> 16) : (wv[k >> 1] & 0xffffu));
          *(LAS u32x2s*)(TD + tid * 4) = (u32x2s){0u, 0u}; }
        __syncthreads();
        { const int gate = w >> 2, mc = w & 3; const bf16* WG = W2T + (size_t)gate * 65536 + (size_t)(hh * 64 + 16 * mc + c16) * 64; LAS bf16* DX = gate ? DA : DW;
          bf16x8s wa[2];
#pragma unroll
          for (int kk = 0; kk < 2; ++kk) wa[kk] = *(const GAS bf16x8s*)(WG + kk * 32 + 8 * g);
          const f32x4 c0 = *(const GAS f32x4*)((gate ? a.in[I_A0] : a.in[I_W0]) + hh * 64 + 16 * mc + 4 * g);
#pragma unroll
          for (int nt = 0; nt < 4; ++nt) { f32x4 acc = {0.f, 0.f, 0.f, 0.f};
#pragma unroll
              for (int kk = 0; kk < 2; ++kk) { const bf16x8s db = *(const LAS bf16x8s*)(DX + (16 * nt + c16) * 72 + kk * 32 + 8 * g); acc = MFMA16(wa[kk], db, acc); }
              f32x4 o;
#pragma unroll
              for (int i = 0; i < 4; ++i) { const float z = acc[i] + c0[i];
                  if (gate == 0) { const float w_log = -log1pf(__expf(-z)) - 0.5f; o[i] = -__expf(w_log); } else o[i] = sigmoidf_(z); }
              *(LAS f32x4*)((gate ? IC : LW) + (16 * nt + c16) * 68 + 16 * mc + 4 * g) = o; }
        }
        __syncthreads();
        if (w == 0) { float acc = 0.f;
#pragma unroll 16
            for (int s = 0; s < 64; ++s) { acc += LW[s * 68 + lane]; LW[s * 68 + lane] = acc; } }
        __syncthreads();
        { const int cq = tid & 15, ch = 4 * cq;
          const f32x4 kkc = *(const GAS f32x4*)(a.in[I_KK] + hh * 64 + ch), kac = *(const GAS f32x4*)(a.in[I_KA] + hh * 64 + ch), rkc = *(const GAS f32x4*)(a.in[I_RK] + hh * 64 + ch);
          const f32x4 gC = *(const LAS f32x4*)(LW + 63 * 68 + ch);
#pragma unroll
          for (int rep = 0; rep < 2; ++rep) { const int t = (tid >> 4) + 32 * rep;
              const u32x2s pr = *(const LAS u32x2s*)(RR + t * 72 + ch), pk_ = *(const LAS u32x2s*)(KK + t * 72 + ch), pv = *(const LAS u32x2s*)(VV + t * 72 + ch);
              const f32x4 G = *(const LAS f32x4*)(LW + t * 68 + ch); f32x4 Gm = {0.f, 0.f, 0.f, 0.f}; if (t > 0) Gm = *(const LAS f32x4*)(LW + (t - 1) * 68 + ch);
              const f32x4 ic = *(const LAS f32x4*)(IC + t * 68 + ch);
              const f32x4 rv = {__uint_as_float(pr.x << 16), __uint_as_float(pr.x & 0xffff0000u), __uint_as_float(pr.y << 16), __uint_as_float(pr.y & 0xffff0000u)};
              const f32x4 kv = {__uint_as_float(pk_.x << 16), __uint_as_float(pk_.x & 0xffff0000u), __uint_as_float(pk_.y << 16), __uint_as_float(pk_.y & 0xffff0000u)};
              const f32x4 vv = {__uint_as_float(pv.x << 16), __uint_as_float(pv.x & 0xffff0000u), __uint_as_float(pv.y << 16), __uint_as_float(pv.y & 0xffff0000u)};
              f32x4 kkv = kv * kkc; float ss = (kkv[0] * kkv[0] + kkv[1] * kkv[1]) + (kkv[2] * kkv[2] + kkv[3] * kkv[3]);
              ss += __shfl_xor(ss, 1); ss += __shfl_xor(ss, 2); ss += __shfl_xor(ss, 4); ss += __shfl_xor(ss, 8);
              const float inv = 1.f / fmaxf(sqrtf(ss), 1e-12f); kkv = kkv * inv;
              const f32x4 k2 = kv * (1.f + (ic - 1.f) * kac);
              float bs = (rv[0] * k2[0] * rkc[0] + rv[1] * k2[1] * rkc[1]) + (rv[2] * k2[2] * rkc[2] + rv[3] * k2[3] * rkc[3]);
              bs += __shfl_xor(bs, 1); bs += __shfl_xor(bs, 2); bs += __shfl_xor(bs, 4); bs += __shfl_xor(bs, 8);
              const f32x4 bb = kkv * ic;
              f32x4 at, rt, bt, kt, bhv, khv;
#pragma unroll
              for (int e = 0; e < 4; ++e) { const float eG = __expf(G[e]), eGm = __expf(Gm[e]), ieG = __expf(-G[e]), eGC = __expf(gC[e] - G[e]);
                  at[e] = -kkv[e] * eGm; rt[e] = rv[e] * eG; bt[e] = bb[e] * ieG; kt[e] = k2[e] * ieG; bhv[e] = bb[e] * eGC; khv[e] = k2[e] * eGC; }
              *(LAS u32x2s*)(AT + t * 72 + ch) = (u32x2s){pk2(at[0], at[1]), pk2(at[2], at[3])}; *(LAS u32x2s*)(RT + t * 72 + ch) = (u32x2s){pk2(rt[0], rt[1]), pk2(rt[2], rt[3])};
              *(LAS u32x2s*)(BT + t * 72 + ch) = (u32x2s){pk2(bt[0], bt[1]), pk2(bt[2], bt[3])}; *(LAS u32x2s*)(KT + t * 72 + ch) = (u32x2s){pk2(kt[0], kt[1]), pk2(kt[2], kt[3])};
#pragma unroll
              for (int e = 0; e < 4; ++e) { BH[(ch + e) * 72 + t] = (bf16)f2bf(bhv[e]); KH[(ch + e) * 72 + t] = (bf16)f2bf(khv[e]); }
              *(GAS u32x2s*)(vt_ + (size_t)t * 2048 + ch * 2) = (u32x2s){pk2(bs * vv[0], bs * vv[1]), pk2(bs * vv[2], bs * vv[3])};
              if (t == 63) { f32x4 gc; gc[0] = __expf(gC[0]); gc[1] = __expf(gC[1]); gc[2] = __expf(gC[2]); gc[3] = __expf(gC[3]); *(GAS f32x4*)((float*)(ws + WS_GC) + (size_t)it * 64 + ch) = gc; } }
        }
        __syncthreads();
        { const int pw = w >> 1; const LAS bf16* FS = (pw & 1) ? KT : BT; const LAS bf16* SE = (pw & 2) ? RT : AT; LAS bf16* OUT = (pw == 0) ? MABh : (pw == 1) ? MAK : (pw == 2) ? MRB : MRK;
#pragma unroll
          for (int q = 0; q < 2; ++q) { const int nt = (w & 1) * 2 + q; bf16x8s sb[2];
#pragma unroll
              for (int kk = 0; kk < 2; ++kk) sb[kk] = *(const LAS bf16x8s*)(SE + (16 * nt + c16) * 72 + kk * 32 + 8 * g);
#pragma unroll
              for (int ms = 0; ms < 4; ++ms) { f32x4 acc = {0.f, 0.f, 0.f, 0.f};
                  if (ms <= nt) {
#pragma unroll
                      for (int kk = 0; kk < 2; ++kk) { const bf16x8s fa = *(const LAS bf16x8s*)(FS + (16 * ms + c16) * 72 + kk * 32 + 8 * g); acc = MFMA16(fa, sb[kk], acc); } }
                  const int t = 16 * nt + c16;
#pragma unroll
                  for (int i = 0; i < 4; ++i) { const int s = 16 * ms + 4 * g + i; const bool keep = (pw < 2) ? (s < t) : (s <= t); acc[i] = keep ? acc[i] : 0.f; }
                  *(LAS u32x2s*)(OUT + t * 72 + 16 * ms + 4 * g) = (u32x2s){pk2(acc[0], acc[1]), pk2(acc[2], acc[3])};
                  if (pw == 0) *(LAS f32x4*)(MAB + t * 68 + 16 * ms + 4 * g) = acc; } }
        }
        __syncthreads();
        if (w == 0) { const int I = g, c = c16; float Tc[16];
#pragma unroll
            for (int t = 0; t < 16; ++t) { float acc = (t == c) ? 1.f : 0.f;
#pragma unroll
                for (int s = 0; s < t; ++s) acc += MAB[(16 * I + t) * 68 + 16 * I + s] * Tc[s];
                Tc[t] = acc; }
#pragma unroll
            for (int tr = 0; tr < 16; ++tr) TD[(I * 64 + tr + 16 * (c >> 2)) * 8 + (c & 3)] = (bf16)f2bf(Tc[tr]);
        } else { for (int e = tid - 64; e < 1152; e += 448) *(LAS v4u*)(XT + e * 8) = (v4u){0u, 0u, 0u, 0u}; }
        __syncthreads();
        { const int jrow = 16 * w + c16;
#pragma unroll
          for (int I = 0; I < 4; ++I) { f32x4 acc;
              if (w < 4) {
#pragma unroll
                  for (int i = 0; i < 4; ++i) acc[i] = bf2f(AT[(16 * I + 4 * g + i) * 72 + 16 * w + c16]);
              } else { acc = (f32x4){0.f, 0.f, 0.f, 0.f};
#pragma unroll
                  for (int kk = 0; kk < 2; ++kk) { const bf16x8s ma = *(const LAS bf16x8s*)(MAK + (16 * I + c16) * 72 + kk * 32 + 8 * g);
                      const bf16x8s vb = *(const LAS bf16x8s*)(VT + (16 * (w - 4) + c16) * 72 + kk * 32 + 8 * g); acc = MFMA16(ma, vb, acc); } }
              if (I > 0) {
#pragma unroll
                  for (int kk = 0; kk < 2; ++kk) if (kk * 32 < 16 * I) { const bf16x8s ma = *(const LAS bf16x8s*)(MABh + (16 * I + c16) * 72 + kk * 32 + 8 * g);
                      const bf16x8s xb = *(const LAS bf16x8s*)(XT + jrow * 72 + kk * 32 + 8 * g); acc = MFMA16(ma, xb, acc); } }
              const bf16x8s zf = pack8(acc, (f32x4){0.f, 0.f, 0.f, 0.f});
              const bf16x8s tf = *(const LAS bf16x8s*)(TD + (I * 64 + lane) * 8);
              const f32x4 x = MFMA16(tf, zf, ((f32x4){0.f, 0.f, 0.f, 0.f}));
              *(LAS u32x2s*)(XT + jrow * 72 + 16 * I + 4 * g) = (u32x2s){pk2(x[0], x[1]), pk2(x[2], x[3])};
              asm volatile("s_waitcnt lgkmcnt(0)" ::: "memory"); }
        }
        __syncthreads();
        { const LAS bf16* WT = XT; const LAS bf16* UT = XT + 64 * 72; const int wq = w & 3;
          if (w < 4) {
              { bf16x8s bh_[2];
#pragma unroll
                for (int kk = 0; kk < 2; ++kk) bh_[kk] = *(const LAS bf16x8s*)(BH + (16 * wq + c16) * 72 + kk * 32 + 8 * g);
                f32x4 acc[4];
#pragma unroll
                for (int nk = 0; nk < 4; ++nk) { acc[nk] = (f32x4){0.f, 0.f, 0.f, 0.f};
#pragma unroll
                    for (int kk = 0; kk < 2; ++kk) { const bf16x8s wa = *(const LAS bf16x8s*)(WT + (16 * nk + c16) * 72 + kk * 32 + 8 * g); acc[nk] = MFMA16(wa, bh_[kk], acc[nk]); } }
#pragma unroll
                for (int kk = 0; kk < 2; ++kk) *(GAS bf16x8s*)(kt_ + tile_chunk_off((wq * 2 + kk) * 64 + lane)) = pack8(acc[2 * kk], acc[2 * kk + 1]); }
              { bf16x8s mb[2];
#pragma unroll
                for (int kk = 0; kk < 2; ++kk) mb[kk] = *(const LAS bf16x8s*)(MRB + (16 * wq + c16) * 72 + kk * 32 + 8 * g);
                f32x4 acc[4];
#pragma unroll
                for (int nk = 0; nk < 4; ++nk) { const u32x2s r0 = *(const LAS u32x2s*)(RT + (16 * wq + c16) * 72 + 16 * nk + 4 * g);
                    acc[nk] = (f32x4){__uint_as_float(r0.x << 16), __uint_as_float(r0.x & 0xffff0000u), __uint_as_float(r0.y << 16), __uint_as_float(r0.y & 0xffff0000u)};
#pragma unroll
                    for (int kk = 0; kk < 2; ++kk) { const bf16x8s wa = *(const LAS bf16x8s*)(WT + (16 * nk + c16) * 72 + kk * 32 + 8 * g); acc[nk] = MFMA16(wa, mb[kk], acc[nk]); } }
#pragma unroll
                for (int kk = 0; kk < 2; ++kk) *(GAS bf16x8s*)(rt_ + tile_chunk_off((wq * 2 + kk) * 64 + lane)) = pack8(acc[2 * kk], acc[2 * kk + 1]); }
          } else {
              bf16x8s ub[2], vb[2];
#pragma unroll
              for (int kk = 0; kk < 2; ++kk) { ub[kk] = *(const LAS bf16x8s*)(UT + (16 * wq + c16) * 72 + kk * 32 + 8 * g); vb[kk] = *(const LAS bf16x8s*)(VT + (16 * wq + c16) * 72 + kk * 32 + 8 * g); }
              f32x4 acc[4];
#pragma unroll
              for (int m = 0; m < 4; ++m) { acc[m] = (f32x4){0.f, 0.f, 0.f, 0.f};
#pragma unroll
                  for (int kk = 0; kk < 2; ++kk) { const bf16x8s ba = *(const LAS bf16x8s*)(BH + (16 * m + c16) * 72 + kk * 32 + 8 * g); acc[m] = MFMA16(ba, ub[kk], acc[m]);
                      const bf16x8s ka = *(const LAS bf16x8s*)(KH + (16 * m + c16) * 72 + kk * 32 + 8 * g); acc[m] = MFMA16(ka, vb[kk], acc[m]); } }
              bf16* QB = (bf16*)(ws + WS_BIG + 3 * RSZ) + (size_t)it * 4096 + (size_t)(wq * 64 + lane) * 16;
              *(GAS bf16x8s*)(QB) = pack8(acc[0], acc[1]); *(GAS bf16x8s*)(QB + 8) = pack8(acc[2], acc[3]);
          }
          { bf16x8s mb[2], mk[2];
#pragma unroll
            for (int kk = 0; kk < 2; ++kk) { mb[kk] = *(const LAS bf16x8s*)(MRB + (16 * wq + c16) * 72 + kk * 32 + 8 * g); mk[kk] = *(const LAS bf16x8s*)(MRK + (16 * wq + c16) * 72 + kk * 32 + 8 * g); }
#pragma unroll
            for (int q = 0; q < 2; ++q) { const int nv = (w >> 2) * 2 + q; f32x4 acc = {0.f, 0.f, 0.f, 0.f};
#pragma unroll
                for (int kk = 0; kk < 2; ++kk) { const bf16x8s ua = *(const LAS bf16x8s*)(UT + (16 * nv + c16) * 72 + kk * 32 + 8 * g); acc = MFMA16(ua, mb[kk], acc);
                    const bf16x8s va = *(const LAS bf16x8s*)(VT + (16 * nv + c16) * 72 + kk * 32 + 8 * g); acc = MFMA16(va, mk[kk], acc); }
                *(GAS u32x2s*)(yl_ + (size_t)(16 * wq + c16) * 2048 + (16 * nv + 4 * g) * 2) = (u32x2s){pk2(acc[0], acc[1]), pk2(acc[2], acc[3])}; } }
        }
        __syncthreads();
    }
}
__device__ __forceinline__ void rw_phase_b(Frame& F, const Args& a) {
    if (F.wave != 0 || blockIdx.x >= 128) return;
    const int bh = blockIdx.x >> 2, nv = blockIdx.x & 3, lane = F.lane, g = lane >> 4, b = bh >> 4, hh = bh & 15;
    unsigned char* const ws = a.ws;
    f32x4 S[4];
#pragma unroll
    for (int m = 0; m < 4; ++m) S[m] = (f32x4){0.f, 0.f, 0.f, 0.f};
    bf16x8s pf[8], qf[2]; f32x4 gm[4];
#define RWB_LOAD(ci_) do { const int it_ = bh * 128 + (ci_); const unsigned char* kt_ = ws + WS_BIG + 5 * RSZ + (((size_t)b * T + (size_t)(ci_) * 64) * 1024 + hh * 64) * 2; \
        _Pragma("unroll") for (int f = 0; f < 8; ++f) pf[f] = *(const GAS bf16x8s*)(kt_ + tile_chunk_off(f * 64 + lane)); \
        const bf16* QB_ = (const bf16*)(ws + WS_BIG + 3 * RSZ) + (size_t)it_ * 4096 + (size_t)(nv * 64 + lane) * 16; qf[0] = *(const GAS bf16x8s*)(QB_); qf[1] = *(const GAS bf16x8s*)(QB_ + 8); \
        _Pragma("unroll") for (int m = 0; m < 4; ++m) gm[m] = *(const GAS f32x4*)((const float*)(ws + WS_GC) + (size_t)it_ * 64 + 16 * m + 4 * g); } while (0)
    RWB_LOAD(0);
#pragma unroll 1
    for (int ci = 0; ci < 128; ++ci) {
        bf16x8s cp[8], cq[2]; f32x4 cg[4];
#pragma unroll
        for (int f = 0; f < 8; ++f) cp[f] = pf[f];
        cq[0] = qf[0]; cq[1] = qf[1];
#pragma unroll
        for (int m = 0; m < 4; ++m) cg[m] = gm[m];
        bf16* QB = (bf16*)(ws + WS_BIG + 3 * RSZ) + (size_t)(bh * 128 + ci) * 4096 + (size_t)(nv * 64 + lane) * 16;
        if (ci + 1 < 128) RWB_LOAD(ci + 1);
        const bf16x8s s0 = pack8(S[0], S[1]), s1 = pack8(S[2], S[3]);
        *(GAS bf16x8s*)(QB) = s0; *(GAS bf16x8s*)(QB + 8) = s1;
        const v4u q0 = __builtin_bit_cast(v4u, cq[0]), q1 = __builtin_bit_cast(v4u, cq[1]); const unsigned qw[8] = {q0.x, q0.y, q0.z, q0.w, q1.x, q1.y, q1.z, q1.w};
#pragma unroll
        for (int m = 0; m < 4; ++m) { f32x4 c;
#pragma unroll
            for (int i = 0; i < 4; ++i) { const unsigned u = qw[m * 2 + (i >> 1)]; const float qv = __uint_as_float((i & 1) ? (u & 0xffff0000u) : (u << 16)); c[i] = cg[m][i] * S[m][i] + qv; }
            c = MFMA16(cp[m * 2 + 0], s0, c); c = MFMA16(cp[m * 2 + 1], s1, c); S[m] = c; }
    }
#undef RWB_LOAD
}
__device__ __forceinline__ void rw_phase_c(Frame& F, const Args& a) {
    const int lane = F.lane, c16 = lane & 15, g = lane >> 4; unsigned char* const ws = a.ws;
    for (int task = blockIdx.x * NWAVES + F.wave; task < 4096 * 4; task += F.G * NWAVES) {
        const int it = task >> 2, mt = task & 3, bh = it >> 7, ci = it & 127, b = bh >> 4, hh = bh & 15;
        const size_t tile = (((size_t)b * T + (size_t)ci * 64) * 1024 + hh * 64) * 2;
        const unsigned char* rt_ = ws + WS_BIG + 4 * RSZ + tile; const unsigned char* bv_ = ws + WS_BIG + 0 * RSZ + tile; const unsigned char* gt_ = ws + WS_BIG + 1 * RSZ + tile; unsigned char* yl_ = ws + WS_BIG + 2 * RSZ + tile;
        bf16x8s rf[2];
#pragma unroll
        for (int kk = 0; kk < 2; ++kk) rf[kk] = *(const GAS bf16x8s*)(rt_ + tile_chunk_off((mt * 2 + kk) * 64 + lane));
        const size_t rowoff = (size_t)(16 * mt + c16) * 2048;
        f32x4 y[4]; float s1 = 0.f;
#pragma unroll
        for (int nv = 0; nv < 4; ++nv) { const bf16* SB = (const bf16*)(ws + WS_BIG + 3 * RSZ) + (size_t)it * 4096 + (size_t)(nv * 64 + lane) * 16;
            const bf16x8s s0 = *(const GAS bf16x8s*)(SB), s1f = *(const GAS bf16x8s*)(SB + 8);
            const u32x2s yl = *(const GAS u32x2s*)(yl_ + rowoff + (16 * nv + 4 * g) * 2);
            f32x4 acc = {__uint_as_float(yl.x << 16), __uint_as_float(yl.x & 0xffff0000u), __uint_as_float(yl.y << 16), __uint_as_float(yl.y & 0xffff0000u)};
            acc = MFMA16(s0, rf[0], acc); acc = MFMA16(s1f, rf[1], acc); y[nv] = acc; s1 += (acc[0] + acc[1]) + (acc[2] + acc[3]); }
        s1 += __shfl_xor(s1, 16); s1 += __shfl_xor(s1, 32); const float mean = s1 * (1.f / 64.f); float s2 = 0.f;
#pragma unroll
        for (int nv = 0; nv < 4; ++nv) { y[nv] = y[nv] - mean; s2 += (y[nv][0] * y[nv][0] + y[nv][1] * y[nv][1]) + (y[nv][2] * y[nv][2] + y[nv][3] * y[nv][3]); }
        s2 += __shfl_xor(s2, 16); s2 += __shfl_xor(s2, 32); const float rstd = 1.f / sqrtf(s2 * (1.f / 64.f) + 64e-5f);
#pragma unroll
        for (int nv = 0; nv < 4; ++nv) { const int vch = hh * 64 + 16 * nv + 4 * g;
            const f32x4 lw_ = *(const GAS f32x4*)(a.in[I_LNW] + vch), lb_ = *(const GAS f32x4*)(a.in[I_LNB] + vch);
            const u32x2s bo = *(const GAS u32x2s*)(bv_ + rowoff + (16 * nv + 4 * g) * 2), gg = *(const GAS u32x2s*)(gt_ + rowoff + (16 * nv + 4 * g) * 2);
            const float b4[4] = {__uint_as_float(bo.x << 16), __uint_as_float(bo.x & 0xffff0000u), __uint_as_float(bo.y << 16), __uint_as_float(bo.y & 0xffff0000u)};
            const float g4[4] = {__uint_as_float(gg.x << 16), __uint_as_float(gg.x & 0xffff0000u), __uint_as_float(gg.y << 16), __uint_as_float(gg.y & 0xffff0000u)};
            float z[4];
#pragma unroll
            for (int i = 0; i < 4; ++i) z[i] = (y[nv][i] * rstd * lw_[i] + lb_[i] + b4[i]) * siluf_(g4[i]);
            *(GAS u32x2s*)(yl_ + rowoff + (16 * nv + 4 * g) * 2) = (u32x2s){pk2(z[0], z[1]), pk2(z[2], z[3])}; }
    }
}
__device__ __forceinline__ void rowwise_a(Frame& F, const Args& a) {
    const int gw = F.vcu * NWAVES + F.wave, NGW = F.G * NWAVES; float* rstd1 = (float*)(a.ws + WS_SMALL);
    for (int m = gw; m < M; m += NGW) {
        const GAS f32x4* xr = (const GAS f32x4*)(a.in[I_X] + (size_t)m * D) + F.lane; GAS f32x4* mr = (GAS f32x4*)(a.out + (size_t)m * D) + F.lane;
        const GAS f32x4* gr = (const GAS f32x4*)(a.in[I_POST]) + F.lane;
        f32x4 v[4], x[4]; float s = 0.f;
#pragma unroll
        for (int j = 0; j < 4; ++j) { v[j] = mr[64 * j]; x[j] = xr[64 * j]; s += (v[j].x * v[j].x + v[j].y * v[j].y) + (v[j].z * v[j].z + v[j].w * v[j].w); }
        const float rstd = 1.f / sqrtf(wave_sum(s) * (1.f / D) + RMS_EPS); float s1 = 0.f;
#pragma unroll
        for (int j = 0; j < 4; ++j) { const f32x4 g = gr[64 * j]; f32x4 o = x[j] + v[j] * rstd * g; mr[64 * j] = o; s1 += (o.x * o.x + o.y * o.y) + (o.z * o.z + o.w * o.w); }
        const float r1 = 1.f / sqrtf(wave_sum(s1) * (1.f / D) + RMS_EPS);
        if (F.lane == 0) rstd1[m] = r1;
    }
}
__device__ __forceinline__ void rowwise_b(Frame& F, const Args& a) {
    const int gw = F.vcu * NWAVES + F.wave, NGW = F.G * NWAVES; const float* rstd1 = (const float*)(a.ws + WS_SMALL);
    for (int m = gw; m < M; m += NGW) {
        const bool first = (m % T) == 0;
        const GAS f32x4* xr = (const GAS f32x4*)(a.out + (size_t)m * D) + F.lane; const GAS f32x4* xp = (const GAS f32x4*)(a.out + (size_t)(first ? m : m - 1) * D) + F.lane;
        const GAS f32x4* gr = (const GAS f32x4*)(a.in[I_PRE] + D) + F.lane;
        const float r1 = rstd1[m], rp = first ? 0.f : rstd1[m - 1];
#pragma unroll
        for (int j = 0; j < 4; ++j) { const f32x4 g = gr[64 * j]; const f32x4 u = xr[64 * j] * r1 * g; const f32x4 up = xp[64 * j] * rp * g; const f32x4 dlt = up - u;
#pragma unroll
            for (int p = 0; p < 6; ++p) { const f32x4 mu = ((const GAS f32x4*)(a.in[I_MU] + p * D) + F.lane)[64 * j]; const f32x4 o = u + dlt * mu;
                GAS unsigned long long* o8 = (GAS unsigned long long*)((bf16*)(a.ws + WS_BIG + (size_t)p * RSZ) + (size_t)m * D) + F.lane;
                o8[64 * j] = (unsigned long long)pk2(o.x, o.y) | ((unsigned long long)pk2(o.z, o.w) << 32); } }
    }
}
__device__ __forceinline__ void rowwise_final(Frame& F, const Args& a) {
    const int gw = F.vcu * NWAVES + F.wave, NGW = F.G * NWAVES; const float* mix1 = (const float*)(a.ws + WS_BIG + 4 * RSZ);
    for (int m = gw; m < M; m += NGW) {
        GAS f32x4* xr = (GAS f32x4*)(a.out + (size_t)m * D) + F.lane; const GAS f32x4* mr = (const GAS f32x4*)(mix1 + (size_t)m * D) + F.lane;
        const GAS f32x4* gr = (const GAS f32x4*)(a.in[I_POST] + D) + F.lane;
        f32x4 v[4]; float s = 0.f;
#pragma unroll
        for (int j = 0; j < 4; ++j) { v[j] = mr[64 * j]; s += (v[j].x * v[j].x + v[j].y * v[j].y) + (v[j].z * v[j].z + v[j].w * v[j].w); }
        const float rstd = 1.f / sqrtf(wave_sum(s) * (1.f / D) + RMS_EPS);
#pragma unroll
        for (int j = 0; j < 4; ++j) { const f32x4 g = gr[64 * j]; xr[64 * j] = xr[64 * j] + v[j] * rstd * g; }
    }
}

__global__ void __launch_bounds__(NWAVES * 64, 2) mk_fwd(Args args) {
    extern __shared__ __attribute__((aligned(16))) unsigned char lds[];
    Frame F;
    F.lds = (LAS unsigned char*)lds;
    F.MISC = (volatile LAS unsigned*)(F.lds + MISC_OFF);
    F.tid = threadIdx.x; F.lane = F.tid & 63; F.wave = __builtin_amdgcn_readfirstlane(F.tid >> 6);
    F.G = gridDim.x; { const int bx = blockIdx.x; F.vcu = (F.G % 8 == 0) ? (bx % 8) * (F.G / 8) + bx / 8 : bx; }
    unsigned char* ws = args.ws;
    F.ctl = (gu32*)(ws + WS_CTL);
    for (int u = F.tid; u < (LDS_BYTES - LDSCTL_OFF) / 4; u += NWAVES * 64) ((LAS unsigned*)(F.lds + LDSCTL_OFF))[u] = 0u;
    __syncthreads();
    XcdBarrier bar; bar.bar = (unsigned*)(F.ctl + CW_BAR); bar.x = 0; bar.st = nullptr;
#if MK_ONE_LAUNCH
    bar = xcd_barrier_post((unsigned*)(F.ctl + CW_BAR), F.MISC + 8);
#define GRID_BAR() xcd_barrier(bar)
#else
#define GRID_BAR() do { } while (0)
#endif
    const int lo = args.ph_lo, hi = args.ph_hi;
#define IN(k) (lo <= (k) && (k) < hi)
#define BOTH(k) (IN(k) && IN((k) + 1))
    bf16* const BIG = (bf16*)(ws + WS_BIG);

    if (IN(0)) { p0_prologue(F, args); rg_prep_weights(F, args); rw_prep_weights(F, args); if (BOTH(0)) GRID_BAR(); }
    if (IN(1)) {
        pg8::Gemm g{(const bf16*)(ws + WS_U0), (const bf16*)(ws + WS_WIN0), M, NPROJ, D, D}; pg8::StaticOrder S; S.init(M, NPROJ, F.G, (int)blockIdx.x);
        pg8::EpiBf16P E{BIG, NPROJ};
        pg8::gemm_phase<pg8::EpiBf16P, pg8::StaticOrder, true, true>(F.lds + RING_OFF, g, S, E);
        if (BOTH(1)) GRID_BAR();
    }
    if (IN(2)) { rg_phase<0>(F, args); __syncthreads(); hg_phase_a(F, args); if (BOTH(2)) GRID_BAR(); }
    if (IN(3)) { rg_scan(F, args); hg_phase_b(F, args); if (BOTH(3)) GRID_BAR(); }
    if (IN(4)) { rg_phase<1>(F, args); __syncthreads(); hg_phase_c(F, args); if (BOTH(4)) GRID_BAR(); }
    if (IN(5)) {
        pg8::Gemm g{BIG + C_RGG, (const bf16*)(ws + WS_WOUT0), M, D, 2048, NPROJ}; pg8::StaticOrder S; S.init(M, D, F.G, (int)blockIdx.x);
        pg8::EpiF32 E{args.out, D};
        pg8::gemm_phase<pg8::EpiF32, pg8::StaticOrder, true, true>(F.lds + RING_OFF, g, S, E);
        if (BOTH(5)) GRID_BAR();
    }
    if (IN(6)) { rowwise_a(F, args); if (BOTH(6)) GRID_BAR(); }
    if (IN(7)) { rowwise_b(F, args); if (BOTH(7)) GRID_BAR(); }
    {
        pg8::EpiL1 E; E.dst0 = BIG + 4 * (RSZ / 2); E.dst1 = BIG + 5 * (RSZ / 2); E.dst2 = BIG; E.dst3 = BIG + 1 * (RSZ / 2); E.d1 = (bf16*)(ws + WS_U0); E.Mrows = M;
        pg8::Gemm g{BIG, (const bf16*)(ws + WS_WIN1), 6 * M, 4608, D, D};
        if (IN(8)) { pg8::GroupOrder S; S.pm0 = 256; S.pn0 = 16; S.n0 = 1; S.pm1 = 320; S.pn1 = 17; S.n1 = 1; S.G = F.G; S.c = (int)blockIdx.x;
            pg8::gemm_phase<pg8::EpiL1, pg8::GroupOrder, true, true>(F.lds + RING_OFF, g, S, E); if (BOTH(8)) GRID_BAR(); }
        if (IN(9)) { pg8::GroupOrder S; S.pm0 = 0; S.pn0 = 0; S.n0 = 4; S.pm1 = 64; S.pn1 = 4; S.n1 = 4; S.G = F.G; S.c = (int)blockIdx.x;
            pg8::gemm_phase<pg8::EpiL1, pg8::GroupOrder, true, true>(F.lds + RING_OFF, g, S, E); if (BOTH(9)) GRID_BAR(); }
        if (IN(10)) { pg8::GroupOrder S; S.pm0 = 128; S.pn0 = 8; S.n0 = 4; S.pm1 = 192; S.pn1 = 12; S.n1 = 4; S.G = F.G; S.c = (int)blockIdx.x;
            pg8::gemm_phase<pg8::EpiL1, pg8::GroupOrder, true, true>(F.lds + RING_OFF, g, S, E); if (BOTH(10)) GRID_BAR(); }
    }
    if (IN(11)) { rw_phase_a(F, args); if (BOTH(11)) GRID_BAR(); }
    if (IN(12)) { rw_phase_b(F, args); if (BOTH(12)) GRID_BAR(); }
    if (IN(13)) { rw_phase_c(F, args); if (BOTH(13)) GRID_BAR(); }
    if (IN(14)) {
        pg8::Gemm g{BIG + 2 * (RSZ / 2), (const bf16*)(ws + WS_WOUT1), M, D, D, D}; pg8::StaticOrder S; S.init(M, D, F.G, (int)blockIdx.x);
        pg8::EpiF32 E{(float*)(ws + WS_BIG + 4 * RSZ), D};
        pg8::gemm_phase<pg8::EpiF32, pg8::StaticOrder, true, true>(F.lds + RING_OFF, g, S, E);
        if (BOTH(14)) GRID_BAR();
    }
    if (IN(15)) rowwise_final(F, args);
#undef IN
#undef BOTH
}

extern "C" void kernel_launch(void* const* d_in, const int* in_sizes, int n_in, void* d_out, int out_size, void* d_ws, size_t ws_size, hipStream_t stream) {
    static int grid = 0;
    if (grid == 0) {
        if (n_in != 28 || in_sizes[0] != M * D || out_size != M * D || ws_size < WS_END) { fprintf(stderr, "kernel_launch: unexpected shapes/workspace (n_in %d, ws %zu)\n", n_in, ws_size); grid = -1; return; }
        int dev = 0, cus = 0, per_cu = 0;
        if (hipGetDevice(&dev) != hipSuccess || hipDeviceGetAttribute(&cus, hipDeviceAttributeMultiprocessorCount, dev) != hipSuccess) { grid = -1; return; }
        if (hipFuncSetAttribute((const void*)mk_fwd, hipFuncAttributeMaxDynamicSharedMemorySize, LDS_BYTES) != hipSuccess) { fprintf(stderr, "kernel_launch: hipFuncSetAttribute failed\n"); grid = -1; return; }
        if (hipOccupancyMaxActiveBlocksPerMultiprocessor(&per_cu, (const void*)mk_fwd, NWAVES * 64, LDS_BYTES) != hipSuccess || per_cu < 1) fprintf(stderr, "kernel_launch: occupancy query reports %d\n", per_cu);
        (void)hipGetLastError();
        grid = cus;
    }
    if (grid < 0) return;
    if (hipMemsetAsync((char*)d_ws + WS_CTL, 0, CTL_ZERO_BYTES, stream) != hipSuccess) return;
    Args a{};
    for (int i = 0; i < 28; ++i) a.in[i] = (const float*)d_in[i];
    a.out = (float*)d_out; a.ws = (unsigned char*)d_ws;
#if MK_ONE_LAUNCH
    a.ph_lo = 0; a.ph_hi = NPHASE; a.li = 0;
    hipLaunchKernelGGL(mk_fwd, dim3(grid), dim3(NWAVES * 64), LDS_BYTES, stream, a);
#else
    for (int li = 0; li < NPHASE; ++li) { a.ph_lo = li; a.ph_hi = li + 1; a.li = li;
        hipLaunchKernelGGL(mk_fwd, dim3(grid), dim3(NWAVES * 64), LDS_BYTES, stream, a); }
#endif
}
```

```cpp
#include <hip/hip_runtime.h>
#include <cstdio>
#include <cstdint>
#include <cmath>
#ifndef MK_ONE_LAUNCH
#define MK_ONE_LAUNCH 1
#endif
#ifndef MK_PROBE
#define MK_PROBE 0
#endif
#define MK_PCAL 0
#define MK_PA0 0
#define MK_PA1 1
#define MK_PB0 1
#define MK_PB1 2
namespace pg8 {
#define PG8_LAS __attribute__((address_space(3)))
typedef unsigned short bf16_t;
typedef short bf16x8 __attribute__((ext_vector_type(8)));
typedef float f32x4 __attribute__((ext_vector_type(4)));
typedef unsigned u32x4 __attribute__((ext_vector_type(4)));
constexpr int BM = 256, BK = 64, HALF = 128, HTB = HALF * BK * 2  , STAGE_BYTES = 8 * HTB, NXCD = 8, WGM = 8;

__host__ __device__ __forceinline__ int lds_byte(int r, int c) { const int st = (r >> 4) * 2 + (c >> 5), rr = r & 15, cc = c & 31, ob = rr * 64 + cc * 2; return st * 1024 + (ob ^ (((ob >> 9) & 1) << 5)); }
__host__ __device__ __forceinline__ void stage_rc(int b, int& R, int& C) { const int st = b / 1024, sb = b % 1024, swz = sb ^ (((sb >> 9) & 1) << 5); R = (st >> 1) * 16 + swz / 64; C = (st & 1) * 32 + (swz % 64) / 2; }
__host__ __device__ __forceinline__ int perm32(int rho) { const int n = rho >> 4, i = rho & 15; return 8 * (i >> 2) + 4 * n + (i & 3); }

struct Unit { int pm, pn; };
struct Gemm { const bf16_t* A; const bf16_t* Bt; int M, N, K, lda; };

struct StaticOrder {
    int nM, nN, nwg, G, c;
    __host__ __device__ void init(int M, int N, int G_, int c_) { nM = M / BM; nN = N / BM; nwg = nM * nN; G = G_; c = c_; }
    __host__ __device__ bool next(int i, Unit& u) const {
        const long L = (long)i * G + c; if (L >= nwg) return false;
        int wgid = (int)L; { const int q = nwg / NXCD, r = nwg % NXCD, xcd = wgid % NXCD, off = wgid / NXCD; wgid = (xcd < r ? xcd * (q + 1) : r * (q + 1) + (xcd - r) * q) + off; }
        const int nig = WGM * nN, gid = wgid / nig, fm = gid * WGM, gsz = (nM - fm) < WGM ? (nM - fm) : WGM;
        u.pm = fm + ((wgid % nig) % gsz); u.pn = (wgid % nig) / gsz; return true;
    }
    __device__ __forceinline__ void a_ready(const Unit&) const {}
    __device__ __forceinline__ void done(const Unit&) const {}
};

__device__ __forceinline__ unsigned cvt_pk_bf16(float lo, float hi) { unsigned r; asm volatile("v_cvt_pk_bf16_f32 %0, %1, %2" : "=v"(r) : "v"(lo), "v"(hi)); return r; }
typedef float f32x2 __attribute__((ext_vector_type(2)));
template <class Epi, class Sched, bool ALIGN_EPI = false, bool SP2 = false>
__device__ __forceinline__ void gemm_phase(PG8_LAS unsigned char* lds, const Gemm g, const Sched& S, const Epi& E) {
    const int tid = threadIdx.x, wid = __builtin_amdgcn_readfirstlane(tid >> 6), lane = tid & 63, wr = wid >> 2, wc = wid & 3, fr = lane & 15, fq = lane >> 4;
    const int K = g.K, nt = K / BK;
    unsigned voffA[2], voffB[2];
#pragma unroll
    for (int i = 0; i < 2; ++i) { int R, C; stage_rc(tid * 16 + i * 8192, R, C); const int Rb = Epi::PERM ? ((R & ~31) + perm32(R & 31)) : R;
        voffA[i] = (unsigned)(R * g.lda + C) * 2u; voffB[i] = (unsigned)(Rb * K + C) * 2u; }
    const size_t kstep = (size_t)(BK * 2);
    const size_t hstepA = (size_t)HALF * g.lda * 2, hstepB = (size_t)HALF * K * 2;
    const size_t tstepA = 2 * hstepA, tstepB = 2 * hstepB;
    const unsigned ldsw = (unsigned)wid * 1024u;
    const int aoff = lds_byte(wr * 64 + fr, fq * 8), boff = lds_byte(wc * 32 + fr, fq * 8);
#define PG8_SA(b, h) (((b) * 2 + (h)) * HTB)
#define PG8_SB(b, h) ((4 + (b) * 2 + (h)) * HTB)
#define PG8_STAGE(bufoff, gbase, voff) do { _Pragma("unroll") for (int _i = 0; _i < 2; ++_i) \
        __builtin_amdgcn_global_load_lds((const unsigned*)((const char*)(gbase) + (voff)[_i]), (PG8_LAS unsigned*)(lds + (bufoff) + ldsw + _i * 8192), 16, 0, 0); } while (0)
#define PG8_LDA(dst, b, h) do { _Pragma("unroll") for (int m = 0; m < 4; ++m) _Pragma("unroll") for (int k = 0; k < 2; ++k) dst[m][k] = *(const PG8_LAS bf16x8*)(lds + PG8_SA(b, h) + aoff + m * 2048 + k * 1024); } while (0)
#define PG8_LDB(dst, b, h) do { _Pragma("unroll") for (int n = 0; n < 2; ++n) _Pragma("unroll") for (int k = 0; k < 2; ++k) dst[n][k] = *(const PG8_LAS bf16x8*)(lds + PG8_SB(b, h) + boff + n * 2048 + k * 1024); } while (0)
#define PG8_MMA(ai, bj, At, Bt) do { __builtin_amdgcn_s_setprio(1); _Pragma("unroll") for (int m = 0; m < 4; ++m) _Pragma("unroll") for (int n = 0; n < 2; ++n) _Pragma("unroll") for (int k = 0; k < 2; ++k) \
        acc[ai][bj][m][n] = __builtin_amdgcn_mfma_f32_16x16x32_bf16(Bt[n][k], At[m][k], acc[ai][bj][m][n], 0, 0, 0); __builtin_amdgcn_s_setprio(0); } while (0)
#define PG8_WAIT_V(n) asm volatile("s_waitcnt vmcnt(" #n ")" ::: "memory")
#define PG8_WAIT_L(n) asm volatile("s_waitcnt lgkmcnt(" #n ")" ::: "memory")
#define PG8_BAR __builtin_amdgcn_s_barrier()
#define PG8_SCHED __builtin_amdgcn_sched_barrier(0)
    Unit cur, nxt; int ui = 0;
    if (!S.next(0, cur)) return;
    f32x4 acc[2][2][4][2];
#pragma unroll
    for (int a = 0; a < 2; ++a)
#pragma unroll
        for (int b = 0; b < 2; ++b)
#pragma unroll
            for (int m = 0; m < 4; ++m)
#pragma unroll
                for (int n = 0; n < 2; ++n) acc[a][b][m][n] = (f32x4){0.f, 0.f, 0.f, 0.f};
    bf16x8 At[4][2], B0[2][2], B1[2][2];
    const char* cA = (const char*)g.A + (size_t)cur.pm * tstepA; const char* cB = (const char*)g.Bt + (size_t)cur.pn * tstepB;
    S.a_ready(cur);
    if constexpr (SP2) {
        PG8_STAGE(PG8_SB(0, 0), cB, voffB); PG8_STAGE(PG8_SB(0, 1), cB + hstepB, voffB); PG8_STAGE(PG8_SA(0, 0), cA, voffA); PG8_STAGE(PG8_SA(0, 1), cA + hstepA, voffA);
        if (wr == 1) PG8_BAR;
        PG8_WAIT_V(2); PG8_BAR;
        PG8_STAGE(PG8_SB(1, 0), cB + kstep, voffB); PG8_STAGE(PG8_SA(1, 0), cA + kstep, voffA); PG8_STAGE(PG8_SB(1, 1), cB + hstepB + kstep, voffB);
        PG8_WAIT_V(6); PG8_BAR;
    } else {
        PG8_STAGE(PG8_SB(0, 0), cB, voffB); PG8_STAGE(PG8_SA(0, 0), cA, voffA); PG8_STAGE(PG8_SB(0, 1), cB + hstepB, voffB); PG8_STAGE(PG8_SA(0, 1), cA + hstepA, voffA);
        if (wr == 1) PG8_BAR;
        PG8_WAIT_V(4); PG8_BAR;
        PG8_STAGE(PG8_SB(1, 0), cB + kstep, voffB); PG8_STAGE(PG8_SA(1, 0), cA + kstep, voffA); PG8_STAGE(PG8_SB(1, 1), cB + hstepB + kstep, voffB);
        PG8_WAIT_V(6); PG8_BAR;
    }
    for (;;) {
        const bool has_next = S.next(ui + 1, nxt);
        const char* nA = has_next ? (const char*)g.A + (size_t)nxt.pm * tstepA : cA; const char* nB = has_next ? (const char*)g.Bt + (size_t)nxt.pn * tstepB : cB;
        for (int t = 0; t < nt; t += 2) {
            const bool last = (t == nt - 2);
            const char* a1 = cA + (size_t)(t + 1) * kstep;
            const char* a2 = last ? nA : cA + (size_t)(t + 2) * kstep; const char* b2 = last ? nB : cB + (size_t)(t + 2) * kstep;
            const char* a3 = a2 + kstep; const char* b3 = b2 + kstep;
            if (last && has_next) S.a_ready(nxt);
            if constexpr (SP2) {
            PG8_LDB(B0, 0, 0); PG8_LDB(B1, 0, 1); PG8_SCHED; PG8_LDA(At, 0, 0); PG8_STAGE(PG8_SA(1, 1), a1 + hstepA, voffA);
            PG8_WAIT_V(8); PG8_WAIT_L(0); PG8_BAR; PG8_MMA(0, 0, At, B0); PG8_MMA(0, 1, At, B1); PG8_BAR; PG8_SCHED;
            PG8_LDA(At, 0, 1); PG8_STAGE(PG8_SB(0, 0), b2, voffB); PG8_STAGE(PG8_SB(0, 1), b2 + hstepB, voffB); PG8_STAGE(PG8_SA(0, 0), a2, voffA);
            PG8_WAIT_V(8); PG8_WAIT_L(0); PG8_BAR; PG8_MMA(1, 0, At, B0); PG8_MMA(1, 1, At, B1); PG8_BAR; PG8_SCHED;
            PG8_LDB(B0, 1, 0); PG8_LDB(B1, 1, 1); PG8_SCHED; PG8_LDA(At, 1, 0); PG8_STAGE(PG8_SA(0, 1), a2 + hstepA, voffA);
            PG8_WAIT_V(8); PG8_WAIT_L(0); PG8_BAR; PG8_MMA(0, 0, At, B0); PG8_MMA(0, 1, At, B1); PG8_BAR; PG8_SCHED;
            PG8_LDA(At, 1, 1); PG8_STAGE(PG8_SB(1, 0), b3, voffB); PG8_STAGE(PG8_SB(1, 1), b3 + hstepB, voffB); PG8_STAGE(PG8_SA(1, 0), a3, voffA);
            PG8_WAIT_V(8); PG8_WAIT_L(0); PG8_BAR; PG8_MMA(1, 0, At, B0); PG8_MMA(1, 1, At, B1); PG8_BAR; PG8_SCHED;
            } else {
            PG8_LDB(B0, 0, 0); PG8_SCHED; PG8_LDA(At, 0, 0); PG8_STAGE(PG8_SA(1, 1), a1 + hstepA, voffA);
            PG8_WAIT_L(8); PG8_BAR; PG8_WAIT_L(0); PG8_MMA(0, 0, At, B0); PG8_BAR; PG8_SCHED;
            PG8_LDB(B1, 0, 1); PG8_STAGE(PG8_SB(0, 0), b2, voffB);
            PG8_BAR; PG8_WAIT_L(0); PG8_MMA(0, 1, At, B1); PG8_BAR;
            PG8_LDA(At, 0, 1); PG8_STAGE(PG8_SA(0, 0), a2, voffA);
            PG8_BAR; PG8_WAIT_L(0); PG8_MMA(1, 0, At, B0); PG8_BAR; PG8_SCHED;
            PG8_STAGE(PG8_SB(0, 1), b2 + hstepB, voffB);
            PG8_WAIT_V(6); PG8_BAR; PG8_MMA(1, 1, At, B1); PG8_BAR;
            PG8_LDB(B0, 1, 0); PG8_SCHED; PG8_LDA(At, 1, 0); PG8_STAGE(PG8_SA(0, 1), a2 + hstepA, voffA);
            PG8_WAIT_L(8); PG8_BAR; PG8_WAIT_L(0); PG8_MMA(0, 0, At, B0); PG8_BAR; PG8_SCHED;
            PG8_LDB(B1, 1, 1); PG8_STAGE(PG8_SB(1, 0), b3, voffB);
            PG8_BAR; PG8_WAIT_L(0); PG8_MMA(0, 1, At, B1); PG8_BAR;
            PG8_LDA(At, 1, 1); PG8_STAGE(PG8_SA(1, 0), a3, voffA);
            PG8_BAR; PG8_WAIT_L(0); PG8_MMA(1, 0, At, B0); PG8_BAR; PG8_SCHED;
            PG8_STAGE(PG8_SB(1, 1), b3 + hstepB, voffB);
            PG8_WAIT_V(6); PG8_BAR; PG8_MMA(1, 1, At, B1); PG8_BAR;
            }
        }
        if constexpr (ALIGN_EPI) { if (wr == 0) PG8_BAR; }
        if constexpr (!Epi::AFTER_DRAIN) { E(acc, cur, wr, wc, fr, fq); S.done(cur); }
        if (!has_next) break;
#pragma unroll
        for (int a = 0; a < 2; ++a)
#pragma unroll
            for (int b = 0; b < 2; ++b)
#pragma unroll
                for (int m = 0; m < 4; ++m)
#pragma unroll
                    for (int n = 0; n < 2; ++n) acc[a][b][m][n] = (f32x4){0.f, 0.f, 0.f, 0.f};
        cur = nxt; cA = nA; cB = nB; ++ui;
        if constexpr (ALIGN_EPI) { if (wr == 1) PG8_BAR; }
    }
    PG8_WAIT_V(0);
    if constexpr (!ALIGN_EPI) { if (wr == 0) PG8_BAR; }
    PG8_BAR;
    if constexpr (Epi::AFTER_DRAIN) { E.fused(acc, cur, wr, wc, fr, fq, lds, wid, lane); S.done(cur); }
#undef PG8_SA
#undef PG8_SB
#undef PG8_STAGE
#undef PG8_LDA
#undef PG8_LDB
#undef PG8_MMA
#undef PG8_WAIT_V
#undef PG8_WAIT_L
#undef PG8_BAR
#undef PG8_SCHED
}
}
namespace pg8 {
typedef unsigned u32x2e __attribute__((ext_vector_type(2)));
struct EpiBf16P {
    static constexpr bool PERM = true, AFTER_DRAIN = false;
    bf16_t* O; int ldc;
    __device__ __forceinline__ void operator()(const f32x4 (&acc)[2][2][4][2], const Unit& u, int wr, int wc, int fr, int fq) const {
        const int row0 = u.pm * BM + wr * 64 + fr, col0 = u.pn * BM + wc * 32 + 8 * fq;
#pragma unroll
        for (int ai = 0; ai < 2; ++ai)
#pragma unroll
            for (int m = 0; m < 4; ++m) { bf16_t* rowp = O + (size_t)(row0 + ai * HALF + m * 16) * ldc + col0;
#pragma unroll
                for (int bj = 0; bj < 2; ++bj) { const f32x4 v0 = acc[ai][bj][m][0], v1 = acc[ai][bj][m][1];
                    u32x4 w; w.x = cvt_pk_bf16(v0[0], v0[1]); w.y = cvt_pk_bf16(v0[2], v0[3]); w.z = cvt_pk_bf16(v1[0], v1[1]); w.w = cvt_pk_bf16(v1[2], v1[3]);
                    *(u32x4*)(rowp + bj * HALF) = w; } }
    }
};
struct EpiF32 {
    static constexpr bool PERM = false, AFTER_DRAIN = false;
    float* O; int ldc;
    __device__ __forceinline__ void operator()(const f32x4 (&acc)[2][2][4][2], const Unit& u, int wr, int wc, int fr, int fq) const {
        const int row0 = u.pm * BM + wr * 64 + fr, col0 = u.pn * BM + wc * 32 + 4 * fq;
#pragma unroll
        for (int ai = 0; ai < 2; ++ai)
#pragma unroll
            for (int m = 0; m < 4; ++m) { float* rowp = O + (size_t)(row0 + ai * HALF + m * 16) * ldc + col0;
#pragma unroll
                for (int bj = 0; bj < 2; ++bj)
#pragma unroll
                    for (int n = 0; n < 2; ++n) *(f32x4*)(rowp + bj * HALF + n * 16) = acc[ai][bj][m][n]; }
    }
};
struct EpiL1 {
    static constexpr bool PERM = true, AFTER_DRAIN = false;
    bf16_t* dst0; bf16_t* dst1; bf16_t* dst2; bf16_t* dst3; bf16_t* d1; int Mrows;
    __device__ __forceinline__ void operator()(const f32x4 (&acc)[2][2][4][2], const Unit& u, int wr, int wc, int fr, int fq) const {
        const int p = u.pm >> 6; const int row0 = (u.pm & 63) * BM + wr * 64 + fr;
        if (p < 4) {
            bf16_t* base = (p == 0) ? dst0 : (p == 1) ? dst1 : (p == 2) ? dst2 : dst3; const int col0 = (u.pn - 4 * p) * BM + wc * 32 + 8 * fq;
#pragma unroll
            for (int ai = 0; ai < 2; ++ai)
#pragma unroll
                for (int m = 0; m < 4; ++m) { bf16_t* rowp = base + (size_t)(row0 + ai * HALF + m * 16) * 1024 + col0;
#pragma unroll
                    for (int bj = 0; bj < 2; ++bj) { const f32x4 v0 = acc[ai][bj][m][0], v1 = acc[ai][bj][m][1];
                        u32x4 w; w.x = cvt_pk_bf16(v0[0], v0[1]); w.y = cvt_pk_bf16(v0[2], v0[3]); w.z = cvt_pk_bf16(v1[0], v1[1]); w.w = cvt_pk_bf16(v1[2], v1[3]);
                        *(u32x4*)(rowp + bj * HALF) = w; } }
        } else if (wc < 2) {
            bf16_t* base = d1 + (size_t)(p - 4) * Mrows * 64; const int col0 = wc * 32 + 8 * fq;
#pragma unroll
            for (int ai = 0; ai < 2; ++ai)
#pragma unroll
                for (int m = 0; m < 4; ++m) { f32x4 v0 = acc[ai][0][m][0], v1 = acc[ai][0][m][1];
                    if (p == 4) { v0[0] = tanhf(v0[0]); v0[1] = tanhf(v0[1]); v0[2] = tanhf(v0[2]); v0[3] = tanhf(v0[3]); v1[0] = tanhf(v1[0]); v1[1] = tanhf(v1[1]); v1[2] = tanhf(v1[2]); v1[3] = tanhf(v1[3]); }
                    u32x4 w; w.x = cvt_pk_bf16(v0[0], v0[1]); w.y = cvt_pk_bf16(v0[2], v0[3]); w.z = cvt_pk_bf16(v1[0], v1[1]); w.w = cvt_pk_bf16(v1[2], v1[3]);
                    *(u32x4*)(base + (size_t)(row0 + ai * HALF + m * 16) * 64 + col0) = w; }
        }
    }
};
struct GroupOrder {
    int pm0, pn0, n0, pm1, pn1, n1, G, c;
    __device__ __forceinline__ bool map(long L, int pmb, int pnb, int nN, Unit& u) const {
        const int nwg = 64 * nN; int wgid = (int)L; { const int q = nwg / NXCD, xcd = wgid % NXCD, off = wgid / NXCD; wgid = xcd * q + off; }
        const int nig = WGM * nN, gid = wgid / nig, fm = gid * WGM;
        u.pm = pmb + fm + ((wgid % nig) % WGM); u.pn = pnb + (wgid % nig) / WGM; return true; }
    __device__ bool next(int i, Unit& u) const {
        long L = (long)i * G + c;
        if (L < 64 * n0) return map(L, pm0, pn0, n0, u);
        L -= 64 * n0;
        if (L < 64 * n1) return map(L, pm1, pn1, n1, u);
        return false;
    }
    __device__ __forceinline__ void a_ready(const Unit&) const {}
    __device__ __forceinline__ void done(const Unit&) const {}
};
}
constexpr int NWAVES = 8;
constexpr int BATCH = 2, T = 8192, D = 1024, M = BATCH * T;
constexpr int NPROJ = 6144;
constexpr int C_RGX = 0, C_HGQ = 1024, C_HGF = 2048, C_HGI = 3072, C_RGG = 4096, C_HGG = 5120;
constexpr float RMS_EPS = 1e-6f;
constexpr int NPHASE = 16;
constexpr size_t MiB = 1u << 20;
constexpr size_t WS_CTL = 0, CTL_ZERO_BYTES = 1 * MiB;
constexpr size_t WS_WIN0 = 1 * MiB;
constexpr size_t WS_WOUT0 = 13 * MiB;
constexpr size_t WS_WIN1 = 17 * MiB;
constexpr size_t WS_WOUT1 = 26 * MiB;
constexpr size_t WS_SMALL = 28 * MiB;
constexpr size_t WS_U0 = 30 * MiB;
constexpr size_t WS_BIG = 62 * MiB;
constexpr size_t WS_END = 254 * MiB;
constexpr size_t RSZ = 32 * MiB;
constexpr int CW_BAR = 4096;
constexpr int RING_OFF = 0, RING_BYTES = 131072;
constexpr int LDSCTL_OFF = RING_BYTES, MISC_OFF = LDSCTL_OFF + 320;
constexpr int LDS_BYTES = 147456;
#define GAS __attribute__((address_space(1)))
#define LAS __attribute__((address_space(3)))
typedef unsigned short bf16;
typedef unsigned v4u __attribute__((ext_vector_type(4)));
typedef float f32x4 __attribute__((ext_vector_type(4)));
typedef short bf16x8 __attribute__((ext_vector_type(8)));
typedef GAS unsigned gu32;
typedef GAS unsigned long long gu64;
#define RLX_AGENT __ATOMIC_RELAXED, __HIP_MEMORY_SCOPE_AGENT
#define LDS_WAIT() asm volatile("s_waitcnt lgkmcnt(0)" ::: "memory")
#define VM_WAIT() asm volatile("s_waitcnt vmcnt(0)" ::: "memory")
__device__ __forceinline__ unsigned long long rt() { return __builtin_amdgcn_s_memrealtime(); }
__device__ __forceinline__ unsigned f2bf(float f) { unsigned u = __builtin_bit_cast(unsigned, f); return (u + 0x7fffu + ((u >> 16) & 1u)) >> 16; }
__device__ __forceinline__ unsigned pk2(float lo, float hi) { return f2bf(lo) | (f2bf(hi) << 16); }
#define XB_TMO      128
#define XB_XCNT(j)  (256  + 64 * (j))
#define XB_XSUB(j)  (1280 + 64 * (j))
#define XB_XGEN(j)  (2304 + 64 * (j))
#define XB_TOP      3328
#define XB_TOPGEN   3392
#define XCD_BAR_WORDS 3456
#define XB_SPIN_CAP (1u << 18)

__device__ __forceinline__ unsigned xb_ld(unsigned* p)              { return __hip_atomic_load(p, __ATOMIC_RELAXED, __HIP_MEMORY_SCOPE_AGENT); }
__device__ __forceinline__ unsigned xb_add(unsigned* p, unsigned v) { return __hip_atomic_fetch_add(p, v, __ATOMIC_RELAXED, __HIP_MEMORY_SCOPE_AGENT); }
__device__ __forceinline__ unsigned xb_xcc_id() { return (unsigned)__builtin_amdgcn_s_getreg((3 << 11) | 20) & 0xFu; }
#define XB_SPIN(cond, bar) do { unsigned _sp = 0; while (cond) { __builtin_amdgcn_s_sleep(1); \
    if ((++_sp & 255u) == 0u) { if (xb_ld(&(bar)[XB_TMO])) break; if (_sp > XB_SPIN_CAP) { atomicAdd(&(bar)[XB_TMO], 1u); break; } } } } while (0)

struct XcdBarrier {
    unsigned* bar; unsigned x;
    volatile LAS unsigned* st;
};

__device__ __forceinline__ XcdBarrier xcd_barrier_post(unsigned* bar, volatile LAS unsigned* st) {
    XcdBarrier b; b.bar = bar; b.x = xb_xcc_id(); b.st = st;
    if (threadIdx.x == 0) (void)xb_add(&bar[XB_XCNT(b.x)], 1u);
    return b;
}
__device__ __forceinline__ void xcd_barrier_complete(unsigned* bar, unsigned x, unsigned& nloc, unsigned& nx) {
    const unsigned G = gridDim.x * gridDim.y * gridDim.z;
    unsigned sum, cnt, mine, sp = 0u;
    for (;;) {
        sum = 0u; cnt = 0u; mine = 0u;
#pragma unroll
        for (unsigned j = 0; j < 16; ++j) { const unsigned c = xb_ld(&bar[XB_XCNT(j)]); sum += c; cnt += (c > 0u) ? 1u : 0u; mine = (j == x) ? c : mine; }
        if (sum == G) break;
        __builtin_amdgcn_s_sleep(1);
        if ((++sp & 255u) == 0u) { if (xb_ld(&bar[XB_TMO])) break; if (sp > XB_SPIN_CAP) { atomicAdd(&bar[XB_TMO], 1u); break; } }
    }
    nloc = mine > 0u ? mine : 1u; nx = cnt > 0u ? cnt : 1u;
}

__device__ __forceinline__ void xcd_barrier(const XcdBarrier& b) {
    asm volatile("s_waitcnt vmcnt(0)" ::: "memory");
    __syncthreads();
    if (threadIdx.x == 0) {
        unsigned* bar = b.bar;
        __builtin_amdgcn_s_waitcnt(0);
        unsigned nloc = b.st[0], nx = b.st[1];
        if (nloc == 0u) { xcd_barrier_complete(bar, b.x, nloc, nx); b.st[0] = nloc; b.st[1] = nx; }
        const unsigned old = xb_add(&bar[XB_XSUB(b.x)], 1u);
        const unsigned gen = old / nloc;
        if (old + 1u == (gen + 1u) * nloc) {
            __builtin_amdgcn_fence(__ATOMIC_RELEASE, "agent");
            asm volatile("s_waitcnt vmcnt(0)" ::: "memory");
            const unsigned og = xb_add(&bar[XB_TOP], 1u);
            const unsigned tg = og / nx;
            if (og + 1u == (tg + 1u) * nx) xb_add(&bar[XB_TOPGEN], 1u);
            else XB_SPIN(xb_ld(&bar[XB_TOPGEN]) == tg, bar);
            __builtin_amdgcn_fence(__ATOMIC_ACQUIRE, "agent");
            xb_add(&bar[XB_XGEN(b.x)], 1u);
            asm volatile("s_waitcnt vmcnt(0)" ::: "memory");
        } else {
            XB_SPIN(xb_ld(&bar[XB_XGEN(b.x)]) == gen, bar);
            __builtin_amdgcn_fence(__ATOMIC_ACQUIRE, "agent");
            asm volatile("s_waitcnt vmcnt(0)" ::: "memory");
        }
    }
    __syncthreads();
}
struct Frame {
    LAS unsigned char* lds;
    volatile LAS unsigned* MISC;
    gu32* ctl;
    int tid, lane, wave;
    int vcu, G;
};
__device__ __forceinline__ float wave_sum(float v) {
#pragma unroll
    for (int o = 1; o < 64; o <<= 1) v += __shfl_xor(v, o);
    return v;
}
__device__ __forceinline__ float bf2f(bf16 u) { return __uint_as_float((unsigned)u << 16); }
__device__ __forceinline__ float sigmoidf_(float x) { return __builtin_amdgcn_rcpf(1.f + __expf(-x)); }
__device__ __forceinline__ float siluf_(float x) { return x * __builtin_amdgcn_rcpf(1.f + __expf(-x)); }

__device__ __forceinline__ void p0_transpose_item(const float* W, int ldw, int c0, bf16* WT, int ldt, int row_off, int nblk, LAS float* scr, int item, int lane) {
    const int kb = item / nblk, nb = item % nblk, k0 = 64 * kb, n0 = 32 * nb;
#pragma unroll 8
    for (int i = 0; i < 32; ++i) { const int kk = 2 * i + (lane >> 5); scr[kk * 33 + (lane & 31)] = W[(size_t)(k0 + kk) * ldw + c0 + n0 + (lane & 31)]; }
    LDS_WAIT(); asm volatile("" ::: "memory");
    const int c = lane & 7;
#pragma unroll
    for (int j = 0; j < 4; ++j) { const int n = (lane >> 3) + 8 * j; const LAS float* s = scr + (8 * c) * 33 + n;
        v4u o; o.x = pk2(s[0 * 33], s[1 * 33]); o.y = pk2(s[2 * 33], s[3 * 33]); o.z = pk2(s[4 * 33], s[5 * 33]); o.w = pk2(s[6 * 33], s[7 * 33]);
        *(GAS v4u*)(WT + (size_t)(row_off + n0 + n) * ldt + k0 + 8 * c) = o; }
    LDS_WAIT(); asm volatile("" ::: "memory");
}
struct Args { const float* in[28]; float* out; unsigned char* ws; int ph_lo, ph_hi, li, pad; };
enum { I_X = 0, I_PRE, I_POST, I_ABWIN, I_ABWOUT, I_CONVW, I_CONVB, I_RGWA, I_RGBA, I_RGWX, I_RGBX, I_LAM, I_HGLB, I_HGNORM, I_MU, I_RWWIN, I_RWWOUT,
       I_W0, I_W1, I_W2, I_A0, I_A1, I_A2, I_KK, I_KA, I_RK, I_LNW, I_LNB };

__device__ __forceinline__ void rms_row_to_bf16(int lane, const float* xrow, const float* gain, bf16* orow) {
    const GAS f32x4* xr = (const GAS f32x4*)xrow + lane; const GAS f32x4* gr = (const GAS f32x4*)gain + lane;
    f32x4 v[4]; float s = 0.f;
#pragma unroll
    for (int j = 0; j < 4; ++j) { v[j] = xr[64 * j]; s += (v[j].x * v[j].x + v[j].y * v[j].y) + (v[j].z * v[j].z + v[j].w * v[j].w); }
    const float rstd = 1.f / sqrtf(wave_sum(s) * (1.f / D) + RMS_EPS);
    GAS unsigned long long* o8 = (GAS unsigned long long*)orow + lane;
#pragma unroll
    for (int j = 0; j < 4; ++j) { const f32x4 g = gr[64 * j];
        o8[64 * j] = (unsigned long long)pk2(v[j].x * rstd * g.x, v[j].y * rstd * g.y) | ((unsigned long long)pk2(v[j].z * rstd * g.z, v[j].w * rstd * g.w) << 32); }
}

__device__ __forceinline__ void p0_prologue(Frame& F, const Args& a) {
    LAS float* scr = (LAS float*)(F.lds + RING_OFF + F.wave * 16384);
    const int gw = F.vcu * NWAVES + F.wave, NGW = F.G * NWAVES;
    bf16* WIN0 = (bf16*)(a.ws + WS_WIN0); bf16* WOUT0 = (bf16*)(a.ws + WS_WOUT0); bf16* WIN1 = (bf16*)(a.ws + WS_WIN1); bf16* WOUT1 = (bf16*)(a.ws + WS_WOUT1);
    constexpr int I_BLK = 16 * 32;
    constexpr int N0 = 6 * I_BLK, N1 = N0 + 32 * 32, N2 = N1 + 4 * I_BLK, N3 = N2 + 32, N4 = N3 + 32, N5 = N4 + I_BLK;
    for (int it = gw; it < N5; it += NGW) {
        if (it < N0) { const int sb = it / I_BLK, r = it % I_BLK; const int db = (sb == 0) ? 0 : (sb == 1) ? 4 : (sb == 2) ? 1 : (sb == 3) ? 2 : (sb == 4) ? 3 : 5;
            p0_transpose_item(a.in[I_ABWIN], NPROJ, sb * 1024, WIN0, 1024, db * 1024, 32, scr, r, F.lane); }
        else if (it < N1) p0_transpose_item(a.in[I_ABWOUT], 1024, 0, WOUT0, 2048, 0, 32, scr, it - N0, F.lane);
        else if (it < N2) { const int p = (it - N1) / I_BLK, r = (it - N1) % I_BLK; p0_transpose_item(a.in[I_RWWIN] + (size_t)p * 1024 * 1024, 1024, 0, WIN1, 1024, p * 1024, 32, scr, r, F.lane); }
        else if (it < N3) p0_transpose_item(a.in[I_W1], 64, 0, WIN1, 1024, 4096, 2, scr, it - N2, F.lane);
        else if (it < N4) p0_transpose_item(a.in[I_A1], 64, 0, WIN1, 1024, 4352, 2, scr, it - N3, F.lane);
        else p0_transpose_item(a.in[I_RWWOUT], 1024, 0, WOUT1, 1024, 0, 32, scr, it - N4, F.lane);
    }
    { const int gt = gw * 64 + F.lane, NGT = NGW * 64; const v4u z = {0u, 0u, 0u, 0u};
      for (int e = gt; e < 2 * 192 * 128; e += NGT) { const int blk = e / (192 * 128), r = e % (192 * 128);
          *(GAS v4u*)(WIN1 + (size_t)(blk ? 4416 : 4160) * 1024 + (size_t)r * 8) = z; } }
    bf16* U0 = (bf16*)(a.ws + WS_U0);
    for (int m = gw; m < M; m += NGW) rms_row_to_bf16(F.lane, a.in[I_X] + (size_t)m * D, a.in[I_PRE], U0 + (size_t)m * D);
}

__device__ __forceinline__ void rg_naive(Frame& F, const Args& a, int item) {
    const int b = item >> 4, n = item & 15, j = F.lane, c = n * 64 + j;
    LAS float* xs = (LAS float*)(F.lds); LAS float* was = xs + 64; LAS float* wxs = was + 4096;
    for (int i = 0; i < 64; ++i) { was[i * 64 + j] = a.in[I_RGWA][(size_t)(n * 64 + i) * 64 + j]; wxs[i * 64 + j] = a.in[I_RGWX][(size_t)(n * 64 + i) * 64 + j]; }
    const float cw0 = a.in[I_CONVW][c], cw1 = a.in[I_CONVW][1024 + c], cw2 = a.in[I_CONVW][2048 + c], cw3 = a.in[I_CONVW][3072 + c], cb = a.in[I_CONVB][c];
    const float ba = a.in[I_RGBA][c], bx = a.in[I_RGBX][c];
    const float sp = log1pf(expf(-a.in[I_LAM][c]));
    bf16* P = (bf16*)(a.ws + WS_BIG) + (size_t)b * T * NPROJ;
    float xm1 = 0.f, xm2 = 0.f, xm3 = 0.f, h = 0.f;
    for (int t0 = 0; t0 < T; t0 += 8) {
        float xin[8], gg[8];
#pragma unroll
        for (int q = 0; q < 8; ++q) { xin[q] = bf2f(P[(size_t)(t0 + q) * NPROJ + C_RGX + c]); gg[q] = bf2f(P[(size_t)(t0 + q) * NPROJ + C_RGG + c]); }
#pragma unroll 1
        for (int q = 0; q < 8; ++q) {
            float xq = xin[0], gq = gg[0];
#pragma unroll
            for (int z = 1; z < 8; ++z) if (q == z) { xq = xin[z]; gq = gg[z]; }
            const float xc = cw0 * xm3 + cw1 * xm2 + cw2 * xm1 + cw3 * xq + cb;
            xm3 = xm2; xm2 = xm1; xm1 = xq;
            asm volatile("" ::: "memory");
            xs[j] = xc;
            asm volatile("s_waitcnt lgkmcnt(0)" ::: "memory");
            float gr = ba, gi = bx;
#pragma unroll
            for (int i = 0; i < 64; ++i) { const float xi = xs[i]; gr += xi * was[i * 64 + j]; gi += xi * wxs[i * 64 + j]; }
            asm volatile("s_waitcnt lgkmcnt(0)" ::: "memory");
            const float gate_r = sigmoidf_(gr), gate_i = sigmoidf_(gi);
            const float log_a = -8.0f * gate_r * sp;
            const float av = expf(log_a), mult = sqrtf(-expm1f(2.0f * log_a));
            h = av * h + mult * (gate_i * xc);
            P[(size_t)(t0 + q) * NPROJ + C_RGG + c] = (bf16)f2bf(h * siluf_(gq));
        }
    }
}

__device__ __forceinline__ void hg_naive(Frame& F, const Args& a, int item) {
    const int b = item >> 3, hh = item & 7, tid = F.tid, v = tid & 127, dg = __builtin_amdgcn_readfirstlane(tid >> 7);
    LAS float* qs = (LAS float*)(F.lds); LAS float* fs = qs + 2048; LAS float* ks = fs + 2048; LAS float* vs = ks + 2048; LAS float* po = vs + 2048;
    bf16* P = (bf16*)(a.ws + WS_BIG) + (size_t)b * T * NPROJ;
    float lb; { const int c = hh * 128 + v; const float l0 = a.in[I_HGLB][c], l1 = a.in[I_HGLB][1024 + c], l2 = a.in[I_HGLB][2048 + c];
        const float mx = fmaxf(l0, fmaxf(l1, l2)); const float e0 = expf(l0 - mx), e1 = expf(l1 - mx), e2 = expf(l2 - mx); lb = e1 / (e0 + e1 + e2); }
    float s[32];
#pragma unroll
    for (int i = 0; i < 32; ++i) s[i] = 0.f;
    for (int t0 = 0; t0 < T; t0 += 16) {
#pragma unroll
        for (int k = 0; k < 4; ++k) { const int t = (tid >> 7) + 4 * k; const bf16* row = P + (size_t)(t0 + t) * NPROJ + hh * 128 + v;
            const float q = bf2f(row[C_HGQ]), fr = bf2f(row[C_HGF]), vi = bf2f(row[C_HGI]);
            const float f = lb + (1.f - lb) * sigmoidf_(fr);
            qs[t * 128 + v] = siluf_(q); fs[t * 128 + v] = f; ks[t * 128 + v] = 1.f - f; vs[t * 128 + v] = vi; }
        __syncthreads();
#pragma unroll 1
        for (int t = 0; t < 16; ++t) {
            float acc = 0.f; const float vv = vs[t * 128 + v];
#pragma unroll
            for (int i = 0; i < 32; ++i) { const int d = dg * 32 + i; s[i] = fs[t * 128 + d] * s[i] + ks[t * 128 + d] * vv; acc += qs[t * 128 + d] * s[i]; }
            po[(t * 4 + dg) * 128 + v] = acc;
        }
        __syncthreads();
#pragma unroll
        for (int tt = 0; tt < 2; ++tt) { const int t = F.wave * 2 + tt;
            float o0 = 0.f, o1 = 0.f;
#pragma unroll
            for (int g = 0; g < 4; ++g) { o0 += po[(t * 4 + g) * 128 + F.lane]; o1 += po[(t * 4 + g) * 128 + 64 + F.lane]; }
            const float ss = wave_sum(o0 * o0 + o1 * o1); const float rstd = 1.f / sqrtf(ss * (1.f / 128.f) + RMS_EPS);
            bf16* row = P + (size_t)(t0 + t) * NPROJ + C_HGG + hh * 128;
            const float g0 = bf2f(row[F.lane]), g1 = bf2f(row[64 + F.lane]);
            row[F.lane] = (bf16)f2bf(o0 * rstd * a.in[I_HGNORM][F.lane] * siluf_(g0));
            row[64 + F.lane] = (bf16)f2bf(o1 * rstd * a.in[I_HGNORM][64 + F.lane] * siluf_(g1)); }
        __syncthreads();
    }
}

__device__ __forceinline__ void rw_naive(Frame& F, const Args& a, int item) {
    const int b = item >> 4, hh = item & 15, j = F.lane, c = hh * 64 + j;
    LAS float* w2s = (LAS float*)(F.lds); LAS float* a2s = w2s + 4096; LAS float* vec = a2s + 4096;
    for (int i = 0; i < 64; ++i) { w2s[i * 64 + j] = a.in[I_W2][(size_t)i * 1024 + c]; a2s[i * 64 + j] = a.in[I_A2][(size_t)i * 1024 + c]; }
    const float w0c = a.in[I_W0][c], a0c = a.in[I_A0][c], kkc = a.in[I_KK][c], kac = a.in[I_KA][c], rkc = a.in[I_RK][c], lnw = a.in[I_LNW][c], lnb = a.in[I_LNB][c];
    const bf16* Rr = (const bf16*)(a.ws + WS_BIG + 4 * RSZ) + (size_t)b * T * 1024 + c;
    const bf16* Rk = (const bf16*)(a.ws + WS_BIG + 5 * RSZ) + (size_t)b * T * 1024 + c;
    const bf16* Rv = (const bf16*)(a.ws + WS_BIG + 0 * RSZ) + (size_t)b * T * 1024 + c;
    const bf16* Rg = (const bf16*)(a.ws + WS_BIG + 1 * RSZ) + (size_t)b * T * 1024 + c;
    bf16* Z = (bf16*)(a.ws + WS_BIG + 2 * RSZ) + (size_t)b * T * 1024 + c;
    const bf16* D1w = (const bf16*)(a.ws + WS_U0) + (size_t)b * T * 64 + j;
    const bf16* D1a = (const bf16*)(a.ws + WS_U0) + (size_t)M * 64 + (size_t)b * T * 64 + j;
    float S[64];
#pragma unroll
    for (int i = 0; i < 64; ++i) S[i] = 0.f;
    asm volatile("s_waitcnt lgkmcnt(0)" ::: "memory");
    for (int t0 = 0; t0 < T; t0 += 8) {
        float pr[8], pk[8], pv[8], pg[8], pdw[8], pda[8];
#pragma unroll
        for (int q = 0; q < 8; ++q) { const size_t o = (size_t)(t0 + q) * 1024; pr[q] = bf2f(Rr[o]); pk[q] = bf2f(Rk[o]); pv[q] = bf2f(Rv[o]); pg[q] = bf2f(Rg[o]);
            pdw[q] = bf2f(D1w[(size_t)(t0 + q) * 64]); pda[q] = bf2f(D1a[(size_t)(t0 + q) * 64]); }
#pragma unroll 1
        for (int q = 0; q < 8; ++q) {
            float rr, kv, vv, gv, dw, da;
            rr = pr[0]; kv = pk[0]; vv = pv[0]; gv = pg[0]; dw = pdw[0]; da = pda[0];
#pragma unroll
            for (int z = 1; z < 8; ++z) if (q == z) { rr = pr[z]; kv = pk[z]; vv = pv[z]; gv = pg[z]; dw = pdw[z]; da = pda[z]; }
            asm volatile("" ::: "memory");
            vec[5 * 64 + j] = dw; vec[6 * 64 + j] = da;
            asm volatile("s_waitcnt lgkmcnt(0)" ::: "memory");
            float zw = w0c, za = a0c;
#pragma unroll 16
            for (int i = 0; i < 64; ++i) { zw += vec[5 * 64 + i] * w2s[i * 64 + j]; za += vec[6 * 64 + i] * a2s[i * 64 + j]; }
            const float w_log = -log1pf(expf(-zw)) - 0.5f;
            const float wdec = expf(-expf(w_log));
            const float iclr = sigmoidf_(za);
            float kkv = kv * kkc; const float nrm = sqrtf(wave_sum(kkv * kkv)); kkv = kkv / fmaxf(nrm, 1e-12f);
            const float k2 = kv * (1.f + (iclr - 1.f) * kac);
            const float bonus = wave_sum(rr * k2 * rkc);
            asm volatile("s_waitcnt lgkmcnt(0)" ::: "memory");
            vec[0 * 64 + j] = wdec; vec[1 * 64 + j] = -kkv; vec[2 * 64 + j] = kkv * iclr; vec[3 * 64 + j] = k2; vec[4 * 64 + j] = rr;
            asm volatile("s_waitcnt lgkmcnt(0)" ::: "memory");
            float sa = 0.f;
#pragma unroll
            for (int k = 0; k < 64; ++k) sa += S[k] * vec[1 * 64 + k];
            float y = 0.f;
#pragma unroll
            for (int k = 0; k < 64; ++k) { S[k] = S[k] * vec[0 * 64 + k] + sa * vec[2 * 64 + k] + vv * vec[3 * 64 + k]; y += S[k] * vec[4 * 64 + k]; }
            asm volatile("s_waitcnt lgkmcnt(0)" ::: "memory");
            const float mean = wave_sum(y) * (1.f / 64.f); const float dy = y - mean; const float var = wave_sum(dy * dy) * (1.f / 64.f);
            float yn = dy * (1.f / sqrtf(var + 64e-5f)) * lnw + lnb;
            yn += bonus * vv;
            Z[(size_t)(t0 + q) * 1024] = (bf16)f2bf(yn * siluf_(gv));
        }
    }
}
constexpr size_t WS_RGA = WS_U0, WS_RGB = WS_U0 + 1 * MiB, WS_HIN = WS_U0 + 2 * MiB, WS_HGD = WS_U0 + 3 * MiB;
constexpr size_t WS_RGW = WS_SMALL + 64 * 1024;
typedef short bf16x8s __attribute__((ext_vector_type(8)));
#define MFMA16(a, b, c) __builtin_amdgcn_mfma_f32_16x16x32_bf16((a), (b), (c), 0, 0, 0)

__device__ __forceinline__ void rg_prep_weights(Frame& F, const Args& a) {
    bf16* RGW = (bf16*)(a.ws + WS_RGW);
    const int gt = (F.vcu * NWAVES + F.wave) * 64 + F.lane, NGT = F.G * NWAVES * 64;
    for (int e = gt; e < 2 * 16 * 64 * 64; e += NGT) { const int gate = e >> 16, n = (e >> 12) & 15, j = (e >> 6) & 63, i = e & 63;
        const float* W = gate ? a.in[I_RGWX] : a.in[I_RGWA]; RGW[e] = (bf16)f2bf(W[(size_t)(n * 64 + i) * 64 + j]); }
}

template <int MODE>
__device__ __forceinline__ void rg_item(Frame& F, const Args& a, int b, int ci, int n) {
    const int lane = F.lane, c16 = lane & 15, g = lane >> 4;
    LAS bf16* XB = (LAS bf16*)(F.lds + F.wave * 9728);
    LAS bf16* XC = XB + 3 * 72;
    bf16* P = (bf16*)(a.ws + WS_BIG) + ((size_t)b * T + (size_t)ci * 64) * NPROJ;
    for (int e = lane; e < 67 * 8; e += 64) { const int r = e >> 3, cq = e & 7; v4u x = {0u, 0u, 0u, 0u};
        if (ci > 0 || r >= 3) x = *(const GAS v4u*)(P + ((long)r - 3) * NPROJ + C_RGX + n * 64 + cq * 8);
        *(LAS v4u*)(XB + r * 72 + cq * 8) = x; }
    v4u gpre[8];
    if (MODE == 1) {
#pragma unroll
        for (int q = 0; q < 8; ++q) gpre[q] = *(const GAS v4u*)(P + (size_t)(q * 8 + (lane >> 3)) * NPROJ + C_RGG + n * 64 + (lane & 7) * 8); }
    asm volatile("s_waitcnt lgkmcnt(0)" ::: "memory");
    {
        const int c = n * 64 + lane;
        const float cw0 = a.in[I_CONVW][c], cw1 = a.in[I_CONVW][1024 + c], cw2 = a.in[I_CONVW][2048 + c], cw3 = a.in[I_CONVW][3072 + c], cb = a.in[I_CONVB][c];
        float x0 = bf2f(XB[66 * 72 + lane]), x1 = bf2f(XB[65 * 72 + lane]), x2 = bf2f(XB[64 * 72 + lane]);
#pragma unroll 8
        for (int t = 63; t >= 0; --t) { const float x3 = bf2f(XB[t * 72 + lane]);
            const float xc = cw0 * x3 + cw1 * x2 + cw2 * x1 + cw3 * x0 + cb;
            XB[(t + 3) * 72 + lane] = (bf16)f2bf(xc); x0 = x1; x1 = x2; x2 = x3; }
    }
    asm volatile("s_waitcnt lgkmcnt(0)" ::: "memory");
    const bf16* RGW = (const bf16*)(a.ws + WS_RGW);
    bf16x8s br[4][2], bi[4][2]; float ba[4], bx[4], sp8[4];
#pragma unroll
    for (int nt = 0; nt < 4; ++nt) { const int c = n * 64 + nt * 16 + c16;
#pragma unroll
        for (int kk = 0; kk < 2; ++kk) { br[nt][kk] = *(const bf16x8s*)(RGW + ((size_t)(n * 64 + nt * 16 + c16)) * 64 + kk * 32 + 8 * g);
                                         bi[nt][kk] = *(const bf16x8s*)(RGW + ((size_t)((16 + n) * 64 + nt * 16 + c16)) * 64 + kk * 32 + 8 * g); }
        ba[nt] = a.in[I_RGBA][c]; bx[nt] = a.in[I_RGBX][c]; sp8[nt] = 8.0f * log1pf(__expf(-a.in[I_LAM][c])); }
    float Ac[4], Bc[4];
#pragma unroll
    for (int nt = 0; nt < 4; ++nt) { Ac[nt] = 1.f; Bc[nt] = 0.f;
        if (MODE == 1) Bc[nt] = ((const float*)(a.ws + WS_HIN))[((size_t)b * 128 + ci) * 1024 + n * 64 + nt * 16 + c16]; }
#pragma unroll 1
    for (int m = 0; m < 4; ++m) {
        bf16x8s af[2];
#pragma unroll
        for (int kk = 0; kk < 2; ++kk) af[kk] = *(const LAS bf16x8s*)(XC + (16 * m + c16) * 72 + kk * 32 + 8 * g);
#pragma unroll
        for (int nt = 0; nt < 4; ++nt) {
            f32x4 ar = {0.f, 0.f, 0.f, 0.f}, ai = {0.f, 0.f, 0.f, 0.f};
#pragma unroll
            for (int kk = 0; kk < 2; ++kk) { ar = MFMA16(af[kk], br[nt][kk], ar); ai = MFMA16(af[kk], bi[nt][kk], ai); }
            float Ainc[4], Binc[4];
#pragma unroll
            for (int i = 0; i < 4; ++i) { const int t = 16 * m + 4 * g + i;
                const float gate_r = sigmoidf_(ar[i] + ba[nt]), gate_i = sigmoidf_(ai[i] + bx[nt]);
                const float log_a = -gate_r * sp8[nt]; const float av = __expf(log_a);
                const float x2_ = 2.0f * log_a;
                const float em = -x2_ * (1.f + x2_ * (0.5f + x2_ * (0.16666667f + x2_ * (0.041666668f + x2_ * (0.0083333338f + x2_ * 0.0013888889f)))));
                const float mult = sqrtf(em);
                const float xc = bf2f(XC[t * 72 + nt * 16 + c16]); const float bv = mult * (gate_i * xc);
                if (i == 0) { Ainc[0] = av; Binc[0] = bv; } else { Ainc[i] = av * Ainc[i - 1]; Binc[i] = av * Binc[i - 1] + bv; } }
            const float A4 = Ainc[3], B4 = Binc[3];
            float Ap = 1.f, Bp = 0.f, At = 1.f, Bt = 0.f;
#pragma unroll
            for (int gp = 0; gp < 4; ++gp) { const float Ag = __shfl(A4, c16 + 16 * gp), Bg = __shfl(B4, c16 + 16 * gp);
                if (gp < g) { Bp = Ag * Bp + Bg; Ap = Ag * Ap; }
                Bt = Ag * Bt + Bg; At = Ag * At; }
            if (MODE == 1) {
                const float hg = Ap * Bc[nt] + Bp;
#pragma unroll
                for (int i = 0; i < 4; ++i) { const int t = 16 * m + 4 * g + i; XC[t * 72 + nt * 16 + c16] = (bf16)f2bf(Ainc[i] * hg + Binc[i]); }
                Bc[nt] = At * Bc[nt] + Bt;
            } else { Bc[nt] = At * Bc[nt] + Bt; Ac[nt] = At * Ac[nt]; }
        }
    }
    if (MODE == 0 && g == 0) {
#pragma unroll
        for (int nt = 0; nt < 4; ++nt) { const size_t o = ((size_t)b * 128 + ci) * 1024 + n * 64 + nt * 16 + c16;
            ((float*)(a.ws + WS_RGA))[o] = Ac[nt]; ((float*)(a.ws + WS_RGB))[o] = Bc[nt]; }
    }
    asm volatile("s_waitcnt lgkmcnt(0)" ::: "memory");
    if (MODE == 1) {
#pragma unroll
        for (int q = 0; q < 8; ++q) { const int t = q * 8 + (lane >> 3), cq = lane & 7;
            const v4u hv = *(const LAS v4u*)(XC + t * 72 + cq * 8); const v4u gv = gpre[q];
            const unsigned hw[4] = {hv.x, hv.y, hv.z, hv.w}, gw[4] = {gv.x, gv.y, gv.z, gv.w}; unsigned ow[4];
#pragma unroll
            for (int k = 0; k < 4; ++k) { const float h0 = __uint_as_float(hw[k] << 16), h1 = __uint_as_float(hw[k] & 0xffff0000u), g0 = __uint_as_float(gw[k] << 16), g1 = __uint_as_float(gw[k] & 0xffff0000u);
                ow[k] = pk2(h0 * siluf_(g0), h1 * siluf_(g1)); }
            *(GAS v4u*)(P + (size_t)t * NPROJ + C_RGG + n * 64 + cq * 8) = (v4u){ow[0], ow[1], ow[2], ow[3]}; }
        asm volatile("s_waitcnt lgkmcnt(0)" ::: "memory");
    }
}
template <int MODE>
__device__ __forceinline__ void rg_phase(Frame& F, const Args& a) {
    for (int it = blockIdx.x; it < 512; it += F.G) { const int b = it >> 8, ci = (it >> 1) & 127, n = (it & 1) * 8 + F.wave; rg_item<MODE>(F, a, b, ci, n); }
}
__device__ __forceinline__ void rg_scan(Frame& F, const Args& a) {
    const int gt = (F.vcu * NWAVES + F.wave) * 64 + F.lane;
    if (gt < 2048) { const int b = gt >> 10, c = gt & 1023; float h = 0.f;
        const float* A = (const float*)(a.ws + WS_RGA) + (size_t)b * 128 * 1024 + c; const float* B = (const float*)(a.ws + WS_RGB) + (size_t)b * 128 * 1024 + c;
        float* H = (float*)(a.ws + WS_HIN) + (size_t)b * 128 * 1024 + c;
#pragma unroll 8
        for (int ci = 0; ci < 128; ++ci) { H[(size_t)ci * 1024] = h; h = A[(size_t)ci * 1024] * h + B[(size_t)ci * 1024]; } }
}
typedef unsigned u32x2s __attribute__((ext_vector_type(2)));
__device__ __forceinline__ void hg_lb8(const Args& a, int hh, int dq, float (&lb)[8]) {
#pragma unroll
    for (int e = 0; e < 8; ++e) { const int c = hh * 128 + dq * 8 + e; const float l0 = a.in[I_HGLB][c], l1 = a.in[I_HGLB][1024 + c], l2 = a.in[I_HGLB][2048 + c];
        const float mx = fmaxf(l0, fmaxf(l1, l2)); const float e0 = __expf(l0 - mx), e1 = __expf(l1 - mx), e2 = __expf(l2 - mx); lb[e] = e1 / (e0 + e1 + e2); }
}
__device__ __forceinline__ void hg_logf(Frame& F, const bf16* Prow0, int hh, const float (&lb)[8], LAS float* G) {
    const int tid = F.tid, dq = tid & 15;
#pragma unroll
    for (int rep = 0; rep < 2; ++rep) { const int t = (tid >> 4) + 32 * rep;
        const v4u raw = *(const GAS v4u*)(Prow0 + (size_t)t * NPROJ + C_HGF + hh * 128 + dq * 8);
        const unsigned w[4] = {raw.x, raw.y, raw.z, raw.w}; float o[8];
#pragma unroll
        for (int e = 0; e < 8; ++e) { const float fr = __uint_as_float((e & 1) ? (w[e >> 1] & 0xffff0000u) : (w[e >> 1] << 16));
            o[e] = __logf(lb[e] + (1.f - lb[e]) * sigmoidf_(fr)); }
        *(LAS f32x4*)(G + t * 128 + dq * 8) = (f32x4){o[0], o[1], o[2], o[3]}; *(LAS f32x4*)(G + t * 128 + dq * 8 + 4) = (f32x4){o[4], o[5], o[6], o[7]}; }
}
__device__ __forceinline__ void hg_cumsum(Frame& F, LAS float* G) {
    if (F.tid < 128) { float acc = 0.f;
#pragma unroll 16
        for (int s = 0; s < 64; ++s) { acc += G[s * 128 + F.tid]; G[s * 128 + F.tid] = acc; } }
}
__device__ __forceinline__ void hg_vt(Frame& F, const bf16* Prow0, int hh, LAS bf16* VT, int tid0, int nthr) {
    for (int e = tid0; e < 1024; e += nthr) { const int s = e >> 4, vq = e & 15;
        const v4u raw = *(const GAS v4u*)(Prow0 + (size_t)s * NPROJ + C_HGI + hh * 128 + vq * 8);
        const unsigned w[4] = {raw.x, raw.y, raw.z, raw.w};
#pragma unroll
        for (int k = 0; k < 8; ++k) VT[(vq * 8 + k) * 72 + s] = (bf16)((k & 1) ? (w[k >> 1] >> 16) : (w[k >> 1] & 0xffffu)); }
}

__device__ __forceinline__ void hg_logf_row(const v4u raw, const float (&lb)[8], LAS float* Gp) {
    const unsigned w[4] = {raw.x, raw.y, raw.z, raw.w}; float o[8];
#pragma unroll
    for (int e = 0; e < 8; ++e) { const float fr = __uint_as_float((e & 1) ? (w[e >> 1] & 0xffff0000u) : (w[e >> 1] << 16)); o[e] = __logf(lb[e] + (1.f - lb[e]) * sigmoidf_(fr)); }
    *(LAS f32x4*)(Gp) = (f32x4){o[0], o[1], o[2], o[3]}; *(LAS f32x4*)(Gp + 4) = (f32x4){o[4], o[5], o[6], o[7]};
}
__device__ __forceinline__ void hg_vt_row(const v4u raw, LAS bf16* VT, int vq, int s) {
    const unsigned w[4] = {raw.x, raw.y, raw.z, raw.w};
#pragma unroll
    for (int k = 0; k < 8; ++k) VT[(vq * 8 + k) * 72 + s] = (bf16)((k & 1) ? (w[k >> 1] >> 16) : (w[k >> 1] & 0xffffu));
}
__device__ __forceinline__ void hg_phase_a(Frame& F, const Args& a) {
    LAS float* G = (LAS float*)(F.lds); LAS bf16* KT = (LAS bf16*)(F.lds + 32768); LAS bf16* VT = (LAS bf16*)(F.lds + 32768 + 18432);
    LAS float* SEGH = (LAS float*)(F.lds + RING_BYTES + 2048);
    bf16* ST = (bf16*)a.out; float* HGD = (float*)(a.ws + WS_HGD);
    const int tid = F.tid, lane = F.lane, c16 = lane & 15, g = lane >> 4, w = F.wave;
    const int blk = blockIdx.x; if (blk >= 256) return;
    const int bh = blk >> 4, b = bh >> 3, hh = bh & 7, ci0 = (blk & 15) * 8, dq = tid & 15, tr = tid >> 4;
    float lb[8]; hg_lb8(a, hh, dq, lb);
    v4u pf[2], pv[2];
#define HGA_PREFETCH(ci_) do { const bf16* P0_ = (const bf16*)(a.ws + WS_BIG) + ((size_t)b * T + (size_t)(ci_) * 64) * NPROJ + hh * 128 + dq * 8; \
        _Pragma("unroll") for (int rep = 0; rep < 2; ++rep) { pf[rep] = *(const GAS v4u*)(P0_ + (size_t)(tr + 32 * rep) * NPROJ + C_HGF); pv[rep] = *(const GAS v4u*)(P0_ + (size_t)(tr + 32 * rep) * NPROJ + C_HGI); } } while (0)
    HGA_PREFETCH(ci0);
#pragma unroll 1
    for (int jj = 0; jj < 8; ++jj) { const int ci = ci0 + jj, it = bh * 128 + ci;
#pragma unroll
        for (int rep = 0; rep < 2; ++rep) { hg_logf_row(pf[rep], lb, G + (tr + 32 * rep) * 128 + dq * 8); hg_vt_row(pv[rep], VT, dq, tr + 32 * rep); }
        if (jj + 1 < 8) HGA_PREFETCH(ci + 1);
        __syncthreads();
        const int d = tid & 127, sg = tid >> 7; float gp[16];
        { float acc = 0.f;
#pragma unroll
          for (int i = 0; i < 16; ++i) { acc += G[(sg * 16 + i) * 128 + d]; gp[i] = acc; }
          SEGH[sg * 128 + d] = acc; }
        __syncthreads();
        {
            const float s0 = SEGH[d], s1 = SEGH[128 + d], s2 = SEGH[256 + d], s3 = SEGH[384 + d];
            const float pre = (sg == 0) ? 0.f : (sg == 1) ? s0 : (sg == 2) ? (s0 + s1) : (s0 + s1 + s2); const float gend = (s0 + s1) + (s2 + s3);
            float prev = 0.f; unsigned pk[8];
#pragma unroll
            for (int i = 0; i < 16; ++i) { const float k = 1.f - __expf(gp[i] - prev); prev = gp[i];
                const unsigned hb = f2bf(k * __expf(gend - (gp[i] + pre))); if (i & 1) pk[i >> 1] |= hb << 16; else pk[i >> 1] = hb; }
            *(LAS v4u*)(KT + d * 72 + sg * 16) = (v4u){pk[0], pk[1], pk[2], pk[3]}; *(LAS v4u*)(KT + d * 72 + sg * 16 + 8) = (v4u){pk[4], pk[5], pk[6], pk[7]};
            if (sg == 0) HGD[(size_t)it * 128 + d] = __expf(gend);
        }
        __syncthreads();
        {
            bf16x8s ka[2];
#pragma unroll
            for (int kk = 0; kk < 2; ++kk) ka[kk] = *(const LAS bf16x8s*)(KT + (16 * w + c16) * 72 + kk * 32 + 8 * g);
#pragma unroll
            for (int nt = 0; nt < 8; ++nt) { f32x4 acc = {0.f, 0.f, 0.f, 0.f};
#pragma unroll
                for (int kk = 0; kk < 2; ++kk) { const bf16x8s vb = *(const LAS bf16x8s*)(VT + (nt * 16 + c16) * 72 + kk * 32 + 8 * g); acc = MFMA16(ka[kk], vb, acc); }
                u32x2s o; o.x = pk2(acc[0], acc[1]); o.y = pk2(acc[2], acc[3]);
                *(GAS u32x2s*)(ST + (size_t)it * 16384 + (size_t)(nt * 16 + c16) * 128 + 16 * w + 4 * g) = o; }
        }
        __syncthreads();
    }
#undef HGA_PREFETCH
}
__device__ __forceinline__ void hg_phase_b(Frame& F, const Args& a) {
    bf16* ST = (bf16*)a.out; const float* HGD = (const float*)(a.ws + WS_HGD);
    const int gt0 = (F.vcu * NWAVES + F.wave) * 64 + F.lane, NGT = F.G * NWAVES * 64;
    for (int gt = gt0; gt < 16 * 8192; gt += NGT) { const int bh = gt >> 13, e2 = gt & 8191, v = e2 >> 6, d = (e2 & 63) * 2;
        unsigned* p = (unsigned*)(ST + (size_t)bh * 128 * 16384 + (size_t)v * 128 + d); const float* dp = HGD + (size_t)bh * 128 * 128 + d;
        float s0 = 0.f, s1 = 0.f;
#pragma unroll 8
        for (int ci = 0; ci < 128; ++ci) { const unsigned u = p[(size_t)ci * 8192]; const float d0 = dp[ci * 128], d1 = dp[ci * 128 + 1];
            p[(size_t)ci * 8192] = pk2(s0, s1);
            s0 = d0 * s0 + __uint_as_float(u << 16); s1 = d1 * s1 + __uint_as_float(u & 0xffff0000u); } }
}
__device__ __forceinline__ void hg_phase_c(Frame& F, const Args& a) {
    LAS float* G = (LAS float*)(F.lds);
    LAS bf16* QT = (LAS bf16*)(F.lds + 32768);
    LAS bf16* KT2 = (LAS bf16*)(F.lds + 32768 + 17408);
    LAS bf16* QG = (LAS bf16*)(F.lds + 32768 + 2 * 17408);
    LAS bf16* VT = (LAS bf16*)(F.lds + 32768 + 3 * 17408);
    LAS bf16* PM = (LAS bf16*)(F.lds + 32768 + 3 * 17408 + 18432);
    LAS float* SS = (LAS float*)(F.lds + 32768 + 3 * 17408 + 18432 + 9216);
    LAS float* SEGH = (LAS float*)(F.lds + RING_BYTES + 2048);
    const bf16* ST = (const bf16*)a.out;
    const int tid = F.tid, lane = F.lane, c16 = lane & 15, g = lane >> 4, w = F.wave;
    const int blk = blockIdx.x; if (blk >= 256) return;
    const int bh = blk >> 4, b = bh >> 3, hh = bh & 7, ci0 = (blk & 15) * 8, dq = tid & 15, tr = tid >> 4;
    float lb[8]; hg_lb8(a, hh, dq, lb);
    const f32x4 gn = *(const GAS f32x4*)(a.in[I_HGNORM] + 16 * w + 4 * g);
    v4u pf[2], pq[2], pv[2]; bf16x8s psa[4]; u32x2s pgg[4];
#define HGC_PREFETCH(ci_) do { bf16* P0_ = (bf16*)(a.ws + WS_BIG) + ((size_t)b * T + (size_t)(ci_) * 64) * NPROJ + hh * 128; \
        _Pragma("unroll") for (int rep = 0; rep < 2; ++rep) { const bf16* r_ = P0_ + (size_t)(tr + 32 * rep) * NPROJ + dq * 8; pf[rep] = *(const GAS v4u*)(r_ + C_HGF); pq[rep] = *(const GAS v4u*)(r_ + C_HGQ); pv[rep] = *(const GAS v4u*)(r_ + C_HGI); } \
        _Pragma("unroll") for (int kk = 0; kk < 4; ++kk) psa[kk] = *(const GAS bf16x8s*)(ST + (size_t)(bh * 128 + (ci_)) * 16384 + (size_t)(16 * w + c16) * 128 + kk * 32 + 8 * g); \
        _Pragma("unroll") for (int nt = 0; nt < 4; ++nt) pgg[nt] = *(const GAS u32x2s*)(P0_ + (size_t)(16 * nt + c16) * NPROJ + C_HGG + 16 * w + 4 * g); } while (0)
    HGC_PREFETCH(ci0);
#pragma unroll 1
    for (int jj = 0; jj < 8; ++jj) { const int ci = ci0 + jj;
        bf16* Prow0 = (bf16*)(a.ws + WS_BIG) + ((size_t)b * T + (size_t)ci * 64) * NPROJ;
        v4u cf[2], cq[2]; bf16x8s sa[4]; u32x2s cgg[4];
#pragma unroll
        for (int rep = 0; rep < 2; ++rep) { cf[rep] = pf[rep]; cq[rep] = pq[rep]; hg_logf_row(pf[rep], lb, G + (tr + 32 * rep) * 128 + dq * 8); hg_vt_row(pv[rep], VT, dq, tr + 32 * rep); }
#pragma unroll
        for (int kk = 0; kk < 4; ++kk) sa[kk] = psa[kk];
#pragma unroll
        for (int nt = 0; nt < 4; ++nt) cgg[nt] = pgg[nt];
        if (jj + 1 < 8) HGC_PREFETCH(ci + 1);
        __syncthreads();
        { const int d = tid & 127, sg = tid >> 7; float acc = 0.f;
#pragma unroll
          for (int i = 0; i < 16; ++i) { acc += G[(sg * 16 + i) * 128 + d]; G[(sg * 16 + i) * 128 + d] = acc; }
          SEGH[sg * 128 + d] = acc; }
        __syncthreads();
        {
            float P1[8], P2[8], P3[8];
#pragma unroll
            for (int e = 0; e < 8; ++e) { const float s0 = SEGH[dq * 8 + e], s1 = SEGH[128 + dq * 8 + e], s2 = SEGH[256 + dq * 8 + e]; P1[e] = s0; P2[e] = s0 + s1; P3[e] = s0 + s1 + s2; }
#pragma unroll
            for (int rep = 0; rep < 2; ++rep) { const int t = tr + 32 * rep; const int q4 = t >> 4;
                const unsigned wq[4] = {cq[rep].x, cq[rep].y, cq[rep].z, cq[rep].w}, wf[4] = {cf[rep].x, cf[rep].y, cf[rep].z, cf[rep].w};
                unsigned oq[4], ok[4], og[4];
#pragma unroll
                for (int e = 0; e < 8; ++e) { const float qv = __uint_as_float((e & 1) ? (wq[e >> 1] & 0xffff0000u) : (wq[e >> 1] << 16));
                    const float fr = __uint_as_float((e & 1) ? (wf[e >> 1] & 0xffff0000u) : (wf[e >> 1] << 16));
                    const float f = lb[e] + (1.f - lb[e]) * sigmoidf_(fr); const float k = 1.f - f; const float qs = siluf_(qv);
                    const float pre = (q4 == 0) ? 0.f : (q4 == 1) ? P1[e] : (q4 == 2) ? P2[e] : P3[e];
                    const float gv = G[t * 128 + dq * 8 + e] + pre, gr = G[31 * 128 + dq * 8 + e] + P1[e];
                    const unsigned hq = f2bf(qs * __expf(gv - gr)), hk = f2bf(k * __expf(gr - gv)), hg_ = f2bf(qs * __expf(gv));
                    if (e & 1) { oq[e >> 1] |= hq << 16; ok[e >> 1] |= hk << 16; og[e >> 1] |= hg_ << 16; } else { oq[e >> 1] = hq; ok[e >> 1] = hk; og[e >> 1] = hg_; } }
                *(LAS v4u*)(QT + t * 136 + dq * 8) = (v4u){oq[0], oq[1], oq[2], oq[3]};
                *(LAS v4u*)(KT2 + t * 136 + dq * 8) = (v4u){ok[0], ok[1], ok[2], ok[3]};
                *(LAS v4u*)(QG + t * 136 + dq * 8) = (v4u){og[0], og[1], og[2], og[3]}; }
        }
        __syncthreads();
        {
            const int ms = w >> 1;
#pragma unroll
            for (int q = 0; q < 2; ++q) { const int nt = (w & 1) * 2 + q; f32x4 acc = {0.f, 0.f, 0.f, 0.f};
                if (ms <= nt) {
#pragma unroll
                    for (int kk = 0; kk < 4; ++kk) { const bf16x8s ka = *(const LAS bf16x8s*)(KT2 + (16 * ms + c16) * 136 + kk * 32 + 8 * g);
                        const bf16x8s qb = *(const LAS bf16x8s*)(QT + (16 * nt + c16) * 136 + kk * 32 + 8 * g); acc = MFMA16(ka, qb, acc); } }
                const int t = 16 * nt + c16; float pvv[4];
#pragma unroll
                for (int i = 0; i < 4; ++i) { const int s_ = 16 * ms + 4 * g + i; pvv[i] = (s_ <= t) ? acc[i] : 0.f; }
                u32x2s o; o.x = pk2(pvv[0], pvv[1]); o.y = pk2(pvv[2], pvv[3]);
                *(LAS u32x2s*)(PM + t * 72 + 16 * ms + 4 * g) = o; }
        }
        __syncthreads();
        {
            bf16x8s va[2];
#pragma unroll
            for (int kk = 0; kk < 2; ++kk) va[kk] = *(const LAS bf16x8s*)(VT + (16 * w + c16) * 72 + kk * 32 + 8 * g);
            f32x4 acc[4];
#pragma unroll
            for (int nt = 0; nt < 4; ++nt) { acc[nt] = (f32x4){0.f, 0.f, 0.f, 0.f};
#pragma unroll
                for (int kk = 0; kk < 2; ++kk) { const bf16x8s pb = *(const LAS bf16x8s*)(PM + (16 * nt + c16) * 72 + kk * 32 + 8 * g); acc[nt] = MFMA16(va[kk], pb, acc[nt]); }
#pragma unroll
                for (int kk = 0; kk < 4; ++kk) { const bf16x8s qb = *(const LAS bf16x8s*)(QG + (16 * nt + c16) * 136 + kk * 32 + 8 * g); acc[nt] = MFMA16(sa[kk], qb, acc[nt]); }
                float p = (acc[nt][0] * acc[nt][0] + acc[nt][1] * acc[nt][1]) + (acc[nt][2] * acc[nt][2] + acc[nt][3] * acc[nt][3]);
                p += __shfl_xor(p, 16); p += __shfl_xor(p, 32);
                if (g == 0) SS[w * 64 + 16 * nt + c16] = p; }
            __syncthreads();
#pragma unroll
            for (int nt = 0; nt < 4; ++nt) { const int t = 16 * nt + c16; float ss = 0.f;
#pragma unroll
                for (int q = 0; q < 8; ++q) ss += SS[q * 64 + t];
                const float rstd = 1.f / sqrtf(ss * (1.f / 128.f) + RMS_EPS);
                u32x2s* gp_ = (u32x2s*)(Prow0 + (size_t)t * NPROJ + C_HGG + hh * 128 + 16 * w + 4 * g); const u32x2s gr = cgg[nt];
                const float g0 = __uint_as_float(gr.x << 16), g1 = __uint_as_float(gr.x & 0xffff0000u), g2 = __uint_as_float(gr.y << 16), g3 = __uint_as_float(gr.y & 0xffff0000u);
                u32x2s o; o.x = pk2(acc[nt][0] * rstd * gn[0] * siluf_(g0), acc[nt][1] * rstd * gn[1] * siluf_(g1));
                o.y = pk2(acc[nt][2] * rstd * gn[2] * siluf_(g2), acc[nt][3] * rstd * gn[3] * siluf_(g3)); *gp_ = o; }
        }
        __syncthreads();
    }
#undef HGC_PREFETCH
}
constexpr size_t WS_W2T = WS_SMALL + 512 * 1024;
constexpr size_t WS_GC = WS_U0 + 8 * MiB;
constexpr int RW_A = 0;
constexpr int RW_B = 18432;
constexpr int RW_C = RW_B + 62464;
constexpr int RW_TD = RW_C + 46080;

__device__ __forceinline__ void rw_prep_weights(Frame& F, const Args& a) {
    bf16* WT = (bf16*)(a.ws + WS_W2T);
    const int gt = (F.vcu * NWAVES + F.wave) * 64 + F.lane, NGT = F.G * NWAVES * 64;
    for (int e = gt; e < 2 * 65536; e += NGT) { const int which = e >> 16, ch = (e >> 6) & 1023, i = e & 63;
        WT[e] = (bf16)f2bf((which ? a.in[I_A2] : a.in[I_W2])[(size_t)i * 1024 + ch]); }
}
__device__ __forceinline__ bf16x8s pack8(const f32x4& lo, const f32x4& hi) {
    v4u p; p.x = pk2(lo[0], lo[1]); p.y = pk2(lo[2], lo[3]); p.z = pk2(hi[0], hi[1]); p.w = pk2(hi[2], hi[3]); return __builtin_bit_cast(bf16x8s, p); }
__device__ __forceinline__ size_t tile_chunk_off(int q) { return (size_t)(q >> 3) * 2048 + (size_t)(q & 7) * 16; }

#if MK_PROBE
#define RWA_STAMP(k) do { if (blockIdx.x == 0 && tid == 0) { ((unsigned long long*)(a.ws + 512 * 1024))[32 + jj * 12 + (k)] = __builtin_amdgcn_s_memrealtime(); } } while (0)
#else
#define RWA_STAMP(k) do { } while (0)
#endif
__device__ __forceinline__ void rw_phase_a(Frame& F, const Args& a) {
    LAS unsigned char* L = F.lds;
    LAS bf16* DW = (LAS bf16*)(L + RW_A); LAS bf16* DA = DW + 4608; LAS bf16* BT = DW; LAS bf16* KT = DA; LAS bf16* XT = DW;
    LAS bf16* RR = (LAS bf16*)(L + RW_B); LAS bf16* KK = RR + 4608; LAS bf16* VV = KK + 4608;
    LAS float* LW = (LAS float*)(L + RW_B + 27648); LAS float* IC = (LAS float*)(L + RW_B + 45056);
    LAS float* MAB = (LAS float*)(L + RW_B); LAS bf16* MABh = (LAS bf16*)(L + RW_B + 17408); LAS bf16* MAK = MABh + 4608; LAS bf16* MRB = MAK + 4608; LAS bf16* MRK = MRB + 4608;
    LAS bf16* VT = (LAS bf16*)(L + RW_C); LAS bf16* AT = VT + 4608; LAS bf16* RT = AT + 4608; LAS bf16* BH = RT + 4608; LAS bf16* KH = BH + 4608;
    LAS bf16* TD = (LAS bf16*)(L + RW_TD);
    const int tid = F.tid, lane = F.lane, c16 = lane & 15, g = lane >> 4, w = F.wave;
    unsigned char* const ws = a.ws;
    const bf16* W2T = (const bf16*)(ws + WS_W2T);
    LAS float* SEG = (LAS float*)(L + RING_BYTES + 1024);
  { const int blk = blockIdx.x; if (blk >= 256) return;
    const int bh = blk >> 3, b = bh >> 4, hh = bh & 15, ci0 = (blk & 7) * 16;
    const int gate = w >> 2, mc = w & 3;
    bf16x8s wa[2];
    { const bf16* WG = W2T + (size_t)gate * 65536 + (size_t)(hh * 64 + 16 * mc + c16) * 64;
#pragma unroll
      for (int kk = 0; kk < 2; ++kk) wa[kk] = *(const GAS bf16x8s*)(WG + kk * 32 + 8 * g); }
    const f32x4 c0 = *(const GAS f32x4*)((gate ? a.in[I_A0] : a.in[I_W0]) + hh * 64 + 16 * mc + 4 * g);
    const int ch = 4 * (tid & 15);
    const f32x4 kkc = *(const GAS f32x4*)(a.in[I_KK] + hh * 64 + ch), kac = *(const GAS f32x4*)(a.in[I_KA] + hh * 64 + ch), rkc = *(const GAS f32x4*)(a.in[I_RK] + hh * 64 + ch);
    v4u nr, nk, nv_, nw, na;
#define RWA_PREFETCH(ci_) do { const size_t r0_ = (size_t)b * T + (size_t)(ci_) * 64 + (tid >> 3); const int cq_ = tid & 7; \
        nr = *(const GAS v4u*)(ws + WS_BIG + 4 * RSZ + (r0_ * 1024 + hh * 64) * 2 + cq_ * 16); nk = *(const GAS v4u*)(ws + WS_BIG + 5 * RSZ + (r0_ * 1024 + hh * 64) * 2 + cq_ * 16); \
        nv_ = *(const GAS v4u*)(ws + WS_BIG + 0 * RSZ + (r0_ * 1024 + hh * 64) * 2 + cq_ * 16); \
        nw = *(const GAS v4u*)(ws + WS_U0 + (r0_ * 64 + cq_ * 8) * 2); na = *(const GAS v4u*)(ws + WS_U0 + ((size_t)M * 64 + r0_ * 64 + cq_ * 8) * 2); } while (0)
    RWA_PREFETCH(ci0);
#pragma unroll 1
    for (int jj = 0; jj < 16; ++jj) {
        const int ci = ci0 + jj, it = bh * 128 + ci; RWA_STAMP(0);
        const size_t row0 = (size_t)b * T + (size_t)ci * 64;
        unsigned char* rt_ = ws + WS_BIG + 4 * RSZ + (row0 * 1024 + hh * 64) * 2;
        unsigned char* kt_ = ws + WS_BIG + 5 * RSZ + (row0 * 1024 + hh * 64) * 2;
        unsigned char* vt_ = ws + WS_BIG + 0 * RSZ + (row0 * 1024 + hh * 64) * 2;
        unsigned char* yl_ = ws + WS_BIG + 2 * RSZ + (row0 * 1024 + hh * 64) * 2;
        { const int t = tid >> 3, cq = tid & 7;
          *(LAS v4u*)(RR + t * 72 + cq * 8) = nr; *(LAS v4u*)(KK + t * 72 + cq * 8) = nk; *(LAS v4u*)(VV + t * 72 + cq * 8) = nv_;
          *(LAS v4u*)(DW + t * 72 + cq * 8) = nw; *(LAS v4u*)(DA + t * 72 + cq * 8) = na;
          const unsigned wv[4] = {nv_.x, nv_.y, nv_.z, nv_.w};
#pragma unroll
          for (int k = 0; k < 8; ++k) VT[(cq * 8 + k) * 72 + t] = (bf16)((k & 1) ? (wv[k >> 1] >> 16) : (wv[k >> 1] & 0xffffu));
          *(LAS u32x2s*)(TD + tid * 4) = (u32x2s){0u, 0u}; }
        if (jj + 1 < 16) RWA_PREFETCH(ci + 1);
        __syncthreads(); RWA_STAMP(1);
        { LAS bf16* DX = gate ? DA : DW;
#pragma unroll
          for (int nt = 0; nt < 4; ++nt) { f32x4 acc = {0.f, 0.f, 0.f, 0.f};
#pragma unroll
              for (int kk = 0; kk < 2; ++kk) { const bf16x8s db = *(const LAS bf16x8s*)(DX + (16 * nt + c16) * 72 + kk * 32 + 8 * g); acc = MFMA16(wa[kk], db, acc); }
              f32x4 o;
#pragma unroll
              for (int i = 0; i < 4; ++i) { const float sg = sigmoidf_(acc[i] + c0[i]); o[i] = gate ? sg : -0.60653065971f * sg; }
              *(LAS f32x4*)((gate ? IC : LW) + (16 * nt + c16) * 68 + 16 * mc + 4 * g) = o; }
        }
        __syncthreads(); RWA_STAMP(2);
        if (w < 4) { float acc = 0.f;
#pragma unroll
            for (int s = 0; s < 16; ++s) { acc += LW[(16 * w + s) * 68 + lane]; LW[(16 * w + s) * 68 + lane] = acc; }
            SEG[w * 64 + lane] = acc; }
        __syncthreads(); RWA_STAMP(3);
        { const f32x4 sg0 = *(const LAS f32x4*)(SEG + ch), sg1 = *(const LAS f32x4*)(SEG + 64 + ch), sg2 = *(const LAS f32x4*)(SEG + 128 + ch);
          const f32x4 P1 = sg0, P2 = sg0 + sg1, P3 = P2 + sg2;
          const f32x4 gC = *(const LAS f32x4*)(LW + 63 * 68 + ch) + P3;
#pragma unroll
          for (int rep = 0; rep < 2; ++rep) { const int t = (tid >> 4) + 32 * rep;
              const u32x2s pr = *(const LAS u32x2s*)(RR + t * 72 + ch), pk_ = *(const LAS u32x2s*)(KK + t * 72 + ch), pv = *(const LAS u32x2s*)(VV + t * 72 + ch);
              const int q4 = t >> 4; f32x4 Pq = {0.f, 0.f, 0.f, 0.f}; if (q4 == 1) Pq = P1; else if (q4 == 2) Pq = P2; else if (q4 == 3) Pq = P3;
              const f32x4 G = *(const LAS f32x4*)(LW + t * 68 + ch) + Pq; f32x4 Gm = Pq; if (t & 15) Gm = *(const LAS f32x4*)(LW + (t - 1) * 68 + ch) + Pq;
              const f32x4 ic = *(const LAS f32x4*)(IC + t * 68 + ch);
              const f32x4 rv = {__uint_as_float(pr.x << 16), __uint_as_float(pr.x & 0xffff0000u), __uint_as_float(pr.y << 16), __uint_as_float(pr.y & 0xffff0000u)};
              const f32x4 kv = {__uint_as_float(pk_.x << 16), __uint_as_float(pk_.x & 0xffff0000u), __uint_as_float(pk_.y << 16), __uint_as_float(pk_.y & 0xffff0000u)};
              const f32x4 vv = {__uint_as_float(pv.x << 16), __uint_as_float(pv.x & 0xffff0000u), __uint_as_float(pv.y << 16), __uint_as_float(pv.y & 0xffff0000u)};
              f32x4 kkv = kv * kkc; float ss = (kkv[0] * kkv[0] + kkv[1] * kkv[1]) + (kkv[2] * kkv[2] + kkv[3] * kkv[3]);
              ss += __shfl_xor(ss, 1); ss += __shfl_xor(ss, 2); ss += __shfl_xor(ss, 4); ss += __shfl_xor(ss, 8);
              const float inv = 1.f / fmaxf(sqrtf(ss), 1e-12f); kkv = kkv * inv;
              const f32x4 k2 = kv * (1.f + (ic - 1.f) * kac);
              float bs = (rv[0] * k2[0] * rkc[0] + rv[1] * k2[1] * rkc[1]) + (rv[2] * k2[2] * rkc[2] + rv[3] * k2[3] * rkc[3]);
              bs += __shfl_xor(bs, 1); bs += __shfl_xor(bs, 2); bs += __shfl_xor(bs, 4); bs += __shfl_xor(bs, 8);
              const f32x4 bb = kkv * ic;
              f32x4 at, rt, bt, kt, bhv, khv;
#pragma unroll
              for (int e = 0; e < 4; ++e) { const float eG = __expf(G[e]), eGm = __expf(Gm[e]), ieG = __expf(-G[e]), eGC = __expf(gC[e] - G[e]);
                  at[e] = -kkv[e] * eGm; rt[e] = rv[e] * eG; bt[e] = bb[e] * ieG; kt[e] = k2[e] * ieG; bhv[e] = bb[e] * eGC; khv[e] = k2[e] * eGC; }
              *(LAS u32x2s*)(AT + t * 72 + ch) = (u32x2s){pk2(at[0], at[1]), pk2(at[2], at[3])}; *(LAS u32x2s*)(RT + t * 72 + ch) = (u32x2s){pk2(rt[0], rt[1]), pk2(rt[2], rt[3])};
              *(LAS u32x2s*)(BT + t * 72 + ch) = (u32x2s){pk2(bt[0], bt[1]), pk2(bt[2], bt[3])}; *(LAS u32x2s*)(KT + t * 72 + ch) = (u32x2s){pk2(kt[0], kt[1]), pk2(kt[2], kt[3])};
#pragma unroll
              for (int e = 0; e < 4; ++e) { BH[(ch + e) * 72 + t] = (bf16)f2bf(bhv[e]); KH[(ch + e) * 72 + t] = (bf16)f2bf(khv[e]); }
              *(GAS u32x2s*)(vt_ + (size_t)t * 2048 + ch * 2) = (u32x2s){pk2(bs * vv[0], bs * vv[1]), pk2(bs * vv[2], bs * vv[3])};
              if (t == 63) { f32x4 gc; gc[0] = __expf(gC[0]); gc[1] = __expf(gC[1]); gc[2] = __expf(gC[2]); gc[3] = __expf(gC[3]); *(GAS f32x4*)((float*)(ws + WS_GC) + (size_t)it * 64 + ch) = gc; } }
        }
        __syncthreads(); RWA_STAMP(4);
        { const int pw = w >> 1; const LAS bf16* FS = (pw & 1) ? KT : BT; const LAS bf16* SE = (pw & 2) ? RT : AT; LAS bf16* OUT = (pw == 0) ? MABh : (pw == 1) ? MAK : (pw == 2) ? MRB : MRK;
#pragma unroll
          for (int q = 0; q < 2; ++q) { const int nt = (w & 1) * 2 + q; bf16x8s sb[2];
#pragma unroll
              for (int kk = 0; kk < 2; ++kk) sb[kk] = *(const LAS bf16x8s*)(SE + (16 * nt + c16) * 72 + kk * 32 + 8 * g);
#pragma unroll
              for (int ms = 0; ms < 4; ++ms) { f32x4 acc = {0.f, 0.f, 0.f, 0.f};
                  if (ms <= nt) {
#pragma unroll
                      for (int kk = 0; kk < 2; ++kk) { const bf16x8s fa = *(const LAS bf16x8s*)(FS + (16 * ms + c16) * 72 + kk * 32 + 8 * g); acc = MFMA16(fa, sb[kk], acc); } }
                  const int t = 16 * nt + c16;
#pragma unroll
                  for (int i = 0; i < 4; ++i) { const int s = 16 * ms + 4 * g + i; const bool keep = (pw < 2) ? (s < t) : (s <= t); acc[i] = keep ? acc[i] : 0.f; }
                  *(LAS u32x2s*)(OUT + t * 72 + 16 * ms + 4 * g) = (u32x2s){pk2(acc[0], acc[1]), pk2(acc[2], acc[3])};
                  if (pw == 0) *(LAS f32x4*)(MAB + t * 68 + 16 * ms + 4 * g) = acc; } }
        }
        __syncthreads(); RWA_STAMP(5);
        if (w == 0) { const int I = g, c = c16; float Tc[16];
#pragma unroll
            for (int t = 0; t < 16; ++t) { float acc = (t == c) ? 1.f : 0.f;
#pragma unroll
                for (int s = 0; s < t; ++s) acc += MAB[(16 * I + t) * 68 + 16 * I + s] * Tc[s];
                Tc[t] = acc; }
#pragma unroll
            for (int tr = 0; tr < 16; ++tr) TD[(I * 64 + tr + 16 * (c >> 2)) * 8 + (c & 3)] = (bf16)f2bf(Tc[tr]);
        } else { for (int e = tid - 64; e < 1152; e += 448) *(LAS v4u*)(XT + e * 8) = (v4u){0u, 0u, 0u, 0u}; }
        __syncthreads(); RWA_STAMP(6);
        { const int jrow = 16 * w + c16;
#pragma unroll
          for (int I = 0; I < 4; ++I) { f32x4 acc;
              if (w < 4) {
#pragma unroll
                  for (int i = 0; i < 4; ++i) acc[i] = bf2f(AT[(16 * I + 4 * g + i) * 72 + 16 * w + c16]);
              } else { acc = (f32x4){0.f, 0.f, 0.f, 0.f};
#pragma unroll
                  for (int kk = 0; kk < 2; ++kk) { const bf16x8s ma = *(const LAS bf16x8s*)(MAK + (16 * I + c16) * 72 + kk * 32 + 8 * g);
                      const bf16x8s vb = *(const LAS bf16x8s*)(VT + (16 * (w - 4) + c16) * 72 + kk * 32 + 8 * g); acc = MFMA16(ma, vb, acc); } }
              if (I > 0) {
#pragma unroll
                  for (int kk = 0; kk < 2; ++kk) if (kk * 32 < 16 * I) { const bf16x8s ma = *(const LAS bf16x8s*)(MABh + (16 * I + c16) * 72 + kk * 32 + 8 * g);
                      const bf16x8s xb = *(const LAS bf16x8s*)(XT + jrow * 72 + kk * 32 + 8 * g); acc = MFMA16(ma, xb, acc); } }
              const bf16x8s zf = pack8(acc, (f32x4){0.f, 0.f, 0.f, 0.f});
              const bf16x8s tf = *(const LAS bf16x8s*)(TD + (I * 64 + lane) * 8);
              const f32x4 x = MFMA16(tf, zf, ((f32x4){0.f, 0.f, 0.f, 0.f}));
              *(LAS u32x2s*)(XT + jrow * 72 + 16 * I + 4 * g) = (u32x2s){pk2(x[0], x[1]), pk2(x[2], x[3])};
              asm volatile("s_waitcnt lgkmcnt(0)" ::: "memory"); }
        }
        __syncthreads(); RWA_STAMP(7);
        { const LAS bf16* WT = XT; const LAS bf16* UT = XT + 64 * 72; const int wq = w & 3;
          if (w < 4) {
              { bf16x8s bh_[2];
#pragma unroll
                for (int kk = 0; kk < 2; ++kk) bh_[kk] = *(const LAS bf16x8s*)(BH + (16 * wq + c16) * 72 + kk * 32 + 8 * g);
                f32x4 acc[4];
#pragma unroll
                for (int nk = 0; nk < 4; ++nk) { acc[nk] = (f32x4){0.f, 0.f, 0.f, 0.f};
#pragma unroll
                    for (int kk = 0; kk < 2; ++kk) { const bf16x8s wa = *(const LAS bf16x8s*)(WT + (16 * nk + c16) * 72 + kk * 32 + 8 * g); acc[nk] = MFMA16(wa, bh_[kk], acc[nk]); } }
#pragma unroll
                for (int kk = 0; kk < 2; ++kk) *(GAS bf16x8s*)(kt_ + tile_chunk_off((wq * 2 + kk) * 64 + lane)) = pack8(acc[2 * kk], acc[2 * kk + 1]); }
              { bf16x8s mb[2];
#pragma unroll
                for (int kk = 0; kk < 2; ++kk) mb[kk] = *(const LAS bf16x8s*)(MRB + (16 * wq + c16) * 72 + kk * 32 + 8 * g);
                f32x4 acc[4];
#pragma unroll
                for (int nk = 0; nk < 4; ++nk) { const u32x2s r0 = *(const LAS u32x2s*)(RT + (16 * wq + c16) * 72 + 16 * nk + 4 * g);
                    acc[nk] = (f32x4){__uint_as_float(r0.x << 16), __uint_as_float(r0.x & 0xffff0000u), __uint_as_float(r0.y << 16), __uint_as_float(r0.y & 0xffff0000u)};
#pragma unroll
                    for (int kk = 0; kk < 2; ++kk) { const bf16x8s wa = *(const LAS bf16x8s*)(WT + (16 * nk + c16) * 72 + kk * 32 + 8 * g); acc[nk] = MFMA16(wa, mb[kk], acc[nk]); } }
#pragma unroll
                for (int kk = 0; kk < 2; ++kk) *(GAS bf16x8s*)(rt_ + tile_chunk_off((wq * 2 + kk) * 64 + lane)) = pack8(acc[2 * kk], acc[2 * kk + 1]); }
          } else {
              bf16x8s ub[2], vb[2];
#pragma unroll
              for (int kk = 0; kk < 2; ++kk) { ub[kk] = *(const LAS bf16x8s*)(UT + (16 * wq + c16) * 72 + kk * 32 + 8 * g); vb[kk] = *(const LAS bf16x8s*)(VT + (16 * wq + c16) * 72 + kk * 32 + 8 * g); }
              f32x4 acc[4];
#pragma unroll
              for (int m = 0; m < 4; ++m) { acc[m] = (f32x4){0.f, 0.f, 0.f, 0.f};
#pragma unroll
                  for (int kk = 0; kk < 2; ++kk) { const bf16x8s ba = *(const LAS bf16x8s*)(BH + (16 * m + c16) * 72 + kk * 32 + 8 * g); acc[m] = MFMA16(ba, ub[kk], acc[m]);
                      const bf16x8s ka = *(const LAS bf16x8s*)(KH + (16 * m + c16) * 72 + kk * 32 + 8 * g); acc[m] = MFMA16(ka, vb[kk], acc[m]); } }
              bf16* QB = (bf16*)(ws + WS_BIG + 3 * RSZ) + (size_t)it * 4096 + (size_t)(wq * 64 + lane) * 16;
              *(GAS bf16x8s*)(QB) = pack8(acc[0], acc[1]); *(GAS bf16x8s*)(QB + 8) = pack8(acc[2], acc[3]);
          }
          { bf16x8s mb[2], mk[2];
#pragma unroll
            for (int kk = 0; kk < 2; ++kk) { mb[kk] = *(const LAS bf16x8s*)(MRB + (16 * wq + c16) * 72 + kk * 32 + 8 * g); mk[kk] = *(const LAS bf16x8s*)(MRK + (16 * wq + c16) * 72 + kk * 32 + 8 * g); }
#pragma unroll
            for (int q = 0; q < 2; ++q) { const int nv = (w >> 2) * 2 + q; f32x4 acc = {0.f, 0.f, 0.f, 0.f};
#pragma unroll
                for (int kk = 0; kk < 2; ++kk) { const bf16x8s ua = *(const LAS bf16x8s*)(UT + (16 * nv + c16) * 72 + kk * 32 + 8 * g); acc = MFMA16(ua, mb[kk], acc);
                    const bf16x8s va = *(const LAS bf16x8s*)(VT + (16 * nv + c16) * 72 + kk * 32 + 8 * g); acc = MFMA16(va, mk[kk], acc); }
                *(GAS u32x2s*)(yl_ + (size_t)(16 * wq + c16) * 2048 + (16 * nv + 4 * g) * 2) = (u32x2s){pk2(acc[0], acc[1]), pk2(acc[2], acc[3])}; } }
        }
        __syncthreads(); RWA_STAMP(8);
    }
#undef RWA_PREFETCH
  }
}
struct RwbSet { bf16x8s pf[8]; bf16x8s qf[2]; f32x4 gm[4]; };
__device__ __forceinline__ void rwb_load(RwbSet& R, const unsigned char* ws, int bh, int b, int hh, int nv, int lane, int g, int ci) {
    if (ci >= 128) return;
    const int it = bh * 128 + ci; const unsigned char* kt_ = ws + WS_BIG + 5 * RSZ + (((size_t)b * T + (size_t)ci * 64) * 1024 + hh * 64) * 2;
#pragma unroll
    for (int f = 0; f < 8; ++f) R.pf[f] = *(const GAS bf16x8s*)(kt_ + tile_chunk_off(f * 64 + lane));
    const bf16* QB = (const bf16*)(ws + WS_BIG + 3 * RSZ) + (size_t)it * 4096 + (size_t)(nv * 64 + lane) * 16; R.qf[0] = *(const GAS bf16x8s*)(QB); R.qf[1] = *(const GAS bf16x8s*)(QB + 8);
#pragma unroll
    for (int m = 0; m < 4; ++m) R.gm[m] = *(const GAS f32x4*)((const float*)(ws + WS_GC) + (size_t)it * 64 + 16 * m + 4 * g);
}
__device__ __forceinline__ void rwb_step(const RwbSet& R, f32x4 (&S)[4], unsigned char* ws, int bh, int nv, int lane, int ci) {
    if (ci >= 128) return;
    bf16* QB = (bf16*)(ws + WS_BIG + 3 * RSZ) + (size_t)(bh * 128 + ci) * 4096 + (size_t)(nv * 64 + lane) * 16;
    const bf16x8s s0 = pack8(S[0], S[1]), s1 = pack8(S[2], S[3]);
    const v4u q0 = __builtin_bit_cast(v4u, R.qf[0]), q1 = __builtin_bit_cast(v4u, R.qf[1]); const unsigned qw[8] = {q0.x, q0.y, q0.z, q0.w, q1.x, q1.y, q1.z, q1.w};
    *(GAS bf16x8s*)(QB) = s0; *(GAS bf16x8s*)(QB + 8) = s1;
#pragma unroll
    for (int m = 0; m < 4; ++m) { f32x4 c;
#pragma unroll
        for (int i = 0; i < 4; ++i) { const unsigned u = qw[m * 2 + (i >> 1)]; const float qv = __uint_as_float((i & 1) ? (u & 0xffff0000u) : (u << 16)); c[i] = R.gm[m][i] * S[m][i] + qv; }
        c = MFMA16(R.pf[m * 2 + 0], s0, c); c = MFMA16(R.pf[m * 2 + 1], s1, c); S[m] = c; }
}
__device__ __forceinline__ void rw_phase_b(Frame& F, const Args& a) {
    if (F.wave != 0 || blockIdx.x >= 128) return;
    const int bh = blockIdx.x >> 2, nv = blockIdx.x & 3, lane = F.lane, g = lane >> 4, b = bh >> 4, hh = bh & 15;
    unsigned char* const ws = a.ws;
    f32x4 S[4];
#pragma unroll
    for (int m = 0; m < 4; ++m) S[m] = (f32x4){0.f, 0.f, 0.f, 0.f};
    RwbSet R0, R1, R2;
    rwb_load(R0, ws, bh, b, hh, nv, lane, g, 0); rwb_load(R1, ws, bh, b, hh, nv, lane, g, 1); rwb_load(R2, ws, bh, b, hh, nv, lane, g, 2);
#pragma unroll 1
    for (int ci = 0; ci < 129; ci += 3) {
        rwb_step(R0, S, ws, bh, nv, lane, ci);     rwb_load(R0, ws, bh, b, hh, nv, lane, g, ci + 3);
        rwb_step(R1, S, ws, bh, nv, lane, ci + 1); rwb_load(R1, ws, bh, b, hh, nv, lane, g, ci + 4);
        rwb_step(R2, S, ws, bh, nv, lane, ci + 2); rwb_load(R2, ws, bh, b, hh, nv, lane, g, ci + 5);
    }
}
__device__ __forceinline__ void rw_phase_c(Frame& F, const Args& a) {
    const int lane = F.lane, c16 = lane & 15, g = lane >> 4; unsigned char* const ws = a.ws;
    for (int task = blockIdx.x * NWAVES + F.wave; task < 4096 * 4; task += F.G * NWAVES) {
        const int it = task >> 2, mt = task & 3, bh = it >> 7, ci = it & 127, b = bh >> 4, hh = bh & 15;
        const size_t tile = (((size_t)b * T + (size_t)ci * 64) * 1024 + hh * 64) * 2;
        const unsigned char* rt_ = ws + WS_BIG + 4 * RSZ + tile; const unsigned char* bv_ = ws + WS_BIG + 0 * RSZ + tile; const unsigned char* gt_ = ws + WS_BIG + 1 * RSZ + tile; unsigned char* yl_ = ws + WS_BIG + 2 * RSZ + tile;
        bf16x8s rf[2];
#pragma unroll
        for (int kk = 0; kk < 2; ++kk) rf[kk] = *(const GAS bf16x8s*)(rt_ + tile_chunk_off((mt * 2 + kk) * 64 + lane));
        const size_t rowoff = (size_t)(16 * mt + c16) * 2048;
        bf16x8s sf[4][2]; u32x2s ylv[4], bov[4], ggv[4]; f32x4 lwv[4], lbv[4];
#pragma unroll
        for (int nv = 0; nv < 4; ++nv) { const bf16* SB = (const bf16*)(ws + WS_BIG + 3 * RSZ) + (size_t)it * 4096 + (size_t)(nv * 64 + lane) * 16;
            sf[nv][0] = *(const GAS bf16x8s*)(SB); sf[nv][1] = *(const GAS bf16x8s*)(SB + 8);
            ylv[nv] = *(const GAS u32x2s*)(yl_ + rowoff + (16 * nv + 4 * g) * 2); bov[nv] = *(const GAS u32x2s*)(bv_ + rowoff + (16 * nv + 4 * g) * 2); ggv[nv] = *(const GAS u32x2s*)(gt_ + rowoff + (16 * nv + 4 * g) * 2);
            lwv[nv] = *(const GAS f32x4*)(a.in[I_LNW] + hh * 64 + 16 * nv + 4 * g); lbv[nv] = *(const GAS f32x4*)(a.in[I_LNB] + hh * 64 + 16 * nv + 4 * g); }
        f32x4 y[4]; float s1 = 0.f;
#pragma unroll
        for (int nv = 0; nv < 4; ++nv) { const u32x2s yl = ylv[nv];
            f32x4 acc = {__uint_as_float(yl.x << 16), __uint_as_float(yl.x & 0xffff0000u), __uint_as_float(yl.y << 16), __uint_as_float(yl.y & 0xffff0000u)};
            acc = MFMA16(sf[nv][0], rf[0], acc); acc = MFMA16(sf[nv][1], rf[1], acc); y[nv] = acc; s1 += (acc[0] + acc[1]) + (acc[2] + acc[3]); }
        s1 += __shfl_xor(s1, 16); s1 += __shfl_xor(s1, 32); const float mean = s1 * (1.f / 64.f); float s2 = 0.f;
#pragma unroll
        for (int nv = 0; nv < 4; ++nv) { y[nv] = y[nv] - mean; s2 += (y[nv][0] * y[nv][0] + y[nv][1] * y[nv][1]) + (y[nv][2] * y[nv][2] + y[nv][3] * y[nv][3]); }
        s2 += __shfl_xor(s2, 16); s2 += __shfl_xor(s2, 32); const float rstd = 1.f / sqrtf(s2 * (1.f / 64.f) + 64e-5f);
#pragma unroll
        for (int nv = 0; nv < 4; ++nv) { const f32x4 lw_ = lwv[nv], lb_ = lbv[nv]; const u32x2s bo = bov[nv], gg = ggv[nv];
            const float b4[4] = {__uint_as_float(bo.x << 16), __uint_as_float(bo.x & 0xffff0000u), __uint_as_float(bo.y << 16), __uint_as_float(bo.y & 0xffff0000u)};
            const float g4[4] = {__uint_as_float(gg.x << 16), __uint_as_float(gg.x & 0xffff0000u), __uint_as_float(gg.y << 16), __uint_as_float(gg.y & 0xffff0000u)};
            float z[4];
#pragma unroll
            for (int i = 0; i < 4; ++i) z[i] = (y[nv][i] * rstd * lw_[i] + lb_[i] + b4[i]) * siluf_(g4[i]);
            *(GAS u32x2s*)(yl_ + rowoff + (16 * nv + 4 * g) * 2) = (u32x2s){pk2(z[0], z[1]), pk2(z[2], z[3])}; }
    }
}
__device__ __forceinline__ void rowwise_a(Frame& F, const Args& a) {
    const int gw = F.vcu * NWAVES + F.wave, NGW = F.G * NWAVES; float* rstd1 = (float*)(a.ws + WS_SMALL);
    for (int m = gw; m < M; m += NGW) {
        const GAS f32x4* xr = (const GAS f32x4*)(a.in[I_X] + (size_t)m * D) + F.lane; GAS f32x4* mr = (GAS f32x4*)(a.out + (size_t)m * D) + F.lane;
        const GAS f32x4* gr = (const GAS f32x4*)(a.in[I_POST]) + F.lane;
        f32x4 v[4], x[4]; float s = 0.f;
#pragma unroll
        for (int j = 0; j < 4; ++j) { v[j] = mr[64 * j]; x[j] = xr[64 * j]; s += (v[j].x * v[j].x + v[j].y * v[j].y) + (v[j].z * v[j].z + v[j].w * v[j].w); }
        const float rstd = 1.f / sqrtf(wave_sum(s) * (1.f / D) + RMS_EPS); float s1 = 0.f;
#pragma unroll
        for (int j = 0; j < 4; ++j) { const f32x4 g = gr[64 * j]; f32x4 o = x[j] + v[j] * rstd * g; mr[64 * j] = o; s1 += (o.x * o.x + o.y * o.y) + (o.z * o.z + o.w * o.w); }
        const float r1 = 1.f / sqrtf(wave_sum(s1) * (1.f / D) + RMS_EPS);
        if (F.lane == 0) rstd1[m] = r1;
    }
}
__device__ __forceinline__ void rowwise_b(Frame& F, const Args& a) {
    const int gw = F.vcu * NWAVES + F.wave, NGW = F.G * NWAVES; const float* rstd1 = (const float*)(a.ws + WS_SMALL);
    for (int m = gw; m < M; m += NGW) {
        const bool first = (m % T) == 0;
        const float r1 = rstd1[m], rp = first ? 0.f : rstd1[m - 1];
#pragma unroll
        for (int hf = 0; hf < 2; ++hf) { const int col = hf * 512 + 8 * F.lane;
            const GAS f32x4* xr = (const GAS f32x4*)(a.out + (size_t)m * D + col); const GAS f32x4* xp = (const GAS f32x4*)(a.out + (size_t)(first ? m : m - 1) * D + col);
            const GAS f32x4* gr = (const GAS f32x4*)(a.in[I_PRE] + D + col);
            f32x4 u[2], dl[2];
#pragma unroll
            for (int q = 0; q < 2; ++q) { const f32x4 g = gr[q]; u[q] = xr[q] * r1 * g; dl[q] = xp[q] * rp * g - u[q]; }
#pragma unroll
            for (int p = 0; p < 6; ++p) { const GAS f32x4* mp = (const GAS f32x4*)(a.in[I_MU] + p * D + col); const f32x4 o0 = u[0] + dl[0] * mp[0], o1 = u[1] + dl[1] * mp[1];
                v4u w; w.x = pk2(o0.x, o0.y); w.y = pk2(o0.z, o0.w); w.z = pk2(o1.x, o1.y); w.w = pk2(o1.z, o1.w);
                *(GAS v4u*)((bf16*)(a.ws + WS_BIG + (size_t)p * RSZ) + (size_t)m * D + col) = w; } }
    }
}
__device__ __forceinline__ void rowwise_final(Frame& F, const Args& a) {
    const int gw = F.vcu * NWAVES + F.wave, NGW = F.G * NWAVES; const float* mix1 = (const float*)(a.ws + WS_BIG + 4 * RSZ);
    for (int m = gw; m < M; m += NGW) {
        GAS f32x4* xr = (GAS f32x4*)(a.out + (size_t)m * D) + F.lane; const GAS f32x4* mr = (const GAS f32x4*)(mix1 + (size_t)m * D) + F.lane;
        const GAS f32x4* gr = (const GAS f32x4*)(a.in[I_POST] + D) + F.lane;
        f32x4 v[4]; float s = 0.f;
#pragma unroll
        for (int j = 0; j < 4; ++j) { v[j] = mr[64 * j]; s += (v[j].x * v[j].x + v[j].y * v[j].y) + (v[j].z * v[j].z + v[j].w * v[j].w); }
        const float rstd = 1.f / sqrtf(wave_sum(s) * (1.f / D) + RMS_EPS);
#pragma unroll
        for (int j = 0; j < 4; ++j) { const f32x4 g = gr[64 * j]; xr[64 * j] = xr[64 * j] + v[j] * rstd * g; }
    }
}

__global__ void __launch_bounds__(NWAVES * 64, 2) mk_fwd(Args args) {
    extern __shared__ __attribute__((aligned(16))) unsigned char lds[];
    Frame F;
    F.lds = (LAS unsigned char*)lds;
    F.MISC = (volatile LAS unsigned*)(F.lds + MISC_OFF);
    F.tid = threadIdx.x; F.lane = F.tid & 63; F.wave = __builtin_amdgcn_readfirstlane(F.tid >> 6);
    F.G = gridDim.x; { const int bx = blockIdx.x; F.vcu = (F.G % 8 == 0) ? (bx % 8) * (F.G / 8) + bx / 8 : bx; }
    unsigned char* ws = args.ws;
    F.ctl = (gu32*)(ws + WS_CTL);
    for (int u = F.tid; u < (LDS_BYTES - LDSCTL_OFF) / 4; u += NWAVES * 64) ((LAS unsigned*)(F.lds + LDSCTL_OFF))[u] = 0u;
    __syncthreads();
    XcdBarrier bar; bar.bar = (unsigned*)(F.ctl + CW_BAR); bar.x = 0; bar.st = nullptr;
#if MK_ONE_LAUNCH
    bar = xcd_barrier_post((unsigned*)(F.ctl + CW_BAR), F.MISC + 8);
#define GRID_BAR() do { xcd_barrier(bar); MK_STAMP(); } while (0)
#else
#define GRID_BAR() do { } while (0)
#endif
#if MK_PROBE
    unsigned long long* const stamps = (unsigned long long*)(ws + 512 * 1024); int n_stamp = 1;
    if (blockIdx.x == 0 && F.tid == 0) stamps[0] = __builtin_amdgcn_s_memrealtime();
#define MK_STAMPX(i) do { if (blockIdx.x == 0 && F.tid == 0) { stamps[i] = __builtin_amdgcn_s_memrealtime(); asm volatile("s_waitcnt vmcnt(0)" ::: "memory"); } } while (0)
#define MK_STAMP() do { if (blockIdx.x == 0 && F.tid == 0) { stamps[n_stamp] = __builtin_amdgcn_s_memrealtime(); asm volatile("s_waitcnt vmcnt(0)" ::: "memory"); } ++n_stamp; } while (0)
#else
#define MK_STAMP() do { } while (0)
#define MK_STAMPX(i) do { } while (0)
#endif
    const int lo = args.ph_lo, hi = args.ph_hi;
#define IN(k) (lo <= (k) && (k) < hi)
#define BOTH(k) (IN(k) && IN((k) + 1))
    bf16* const BIG = (bf16*)(ws + WS_BIG);

    if (IN(0)) { p0_prologue(F, args); rg_prep_weights(F, args); rw_prep_weights(F, args); if (BOTH(0)) GRID_BAR(); }
    if (IN(1)) {
        pg8::Gemm g{(const bf16*)(ws + WS_U0), (const bf16*)(ws + WS_WIN0), M, NPROJ, D, D}; pg8::StaticOrder S; S.init(M, NPROJ, F.G, (int)blockIdx.x);
        pg8::EpiBf16P E{BIG, NPROJ};
        pg8::gemm_phase<pg8::EpiBf16P, pg8::StaticOrder, true, true>(F.lds + RING_OFF, g, S, E);
        if (BOTH(1)) GRID_BAR();
    }
    if (IN(2)) { rg_phase<0>(F, args); __syncthreads(); MK_STAMPX(20); hg_phase_a(F, args); if (BOTH(2)) GRID_BAR(); }
    if (IN(3)) { rg_scan(F, args); hg_phase_b(F, args); if (BOTH(3)) GRID_BAR(); }
    if (IN(4)) { rg_phase<1>(F, args); __syncthreads(); MK_STAMPX(21); hg_phase_c(F, args); if (BOTH(4)) GRID_BAR(); }
    if (IN(5)) {
        pg8::Gemm g{BIG + C_RGG, (const bf16*)(ws + WS_WOUT0), M, D, 2048, NPROJ}; pg8::StaticOrder S; S.init(M, D, F.G, (int)blockIdx.x);
        pg8::EpiF32 E{args.out, D};
        pg8::gemm_phase<pg8::EpiF32, pg8::StaticOrder, true, true>(F.lds + RING_OFF, g, S, E);
        if (BOTH(5)) GRID_BAR();
    }
    if (IN(6)) { rowwise_a(F, args); if (BOTH(6)) GRID_BAR(); }
    if (IN(7)) { rowwise_b(F, args); if (BOTH(7)) GRID_BAR(); }
    {
        pg8::EpiL1 E; E.dst0 = BIG + 4 * (RSZ / 2); E.dst1 = BIG + 5 * (RSZ / 2); E.dst2 = BIG; E.dst3 = BIG + 1 * (RSZ / 2); E.d1 = (bf16*)(ws + WS_U0); E.Mrows = M;
        pg8::Gemm g{BIG, (const bf16*)(ws + WS_WIN1), 6 * M, 4608, D, D};
        if (IN(8)) { pg8::GroupOrder S; S.pm0 = 256; S.pn0 = 16; S.n0 = 1; S.pm1 = 320; S.pn1 = 17; S.n1 = 1; S.G = F.G; S.c = (int)blockIdx.x;
            pg8::gemm_phase<pg8::EpiL1, pg8::GroupOrder, true, true>(F.lds + RING_OFF, g, S, E); if (BOTH(8)) GRID_BAR(); }
        if (IN(9)) { pg8::GroupOrder S; S.pm0 = 0; S.pn0 = 0; S.n0 = 4; S.pm1 = 64; S.pn1 = 4; S.n1 = 4; S.G = F.G; S.c = (int)blockIdx.x;
            pg8::gemm_phase<pg8::EpiL1, pg8::GroupOrder, true, true>(F.lds + RING_OFF, g, S, E); if (BOTH(9)) GRID_BAR(); }
        if (IN(10)) { pg8::GroupOrder S; S.pm0 = 128; S.pn0 = 8; S.n0 = 4; S.pm1 = 192; S.pn1 = 12; S.n1 = 4; S.G = F.G; S.c = (int)blockIdx.x;
            pg8::gemm_phase<pg8::EpiL1, pg8::GroupOrder, true, true>(F.lds + RING_OFF, g, S, E); if (BOTH(10)) GRID_BAR(); }
    }
    if (IN(11)) { rw_phase_a(F, args); if (BOTH(11)) GRID_BAR(); }
    if (IN(12)) { rw_phase_b(F, args); if (BOTH(12)) GRID_BAR(); }
    if (IN(13)) { rw_phase_c(F, args); if (BOTH(13)) GRID_BAR(); }
    if (IN(14)) {
        pg8::Gemm g{BIG + 2 * (RSZ / 2), (const bf16*)(ws + WS_WOUT1), M, D, D, D}; pg8::StaticOrder S; S.init(M, D, F.G, (int)blockIdx.x);
        pg8::EpiF32 E{(float*)(ws + WS_BIG + 4 * RSZ), D};
        pg8::gemm_phase<pg8::EpiF32, pg8::StaticOrder, true, true>(F.lds + RING_OFF, g, S, E);
        if (BOTH(14)) GRID_BAR();
    }
    if (IN(15)) { rowwise_final(F, args);
#if MK_PROBE
        {
            __syncthreads();
            const float dA = (float)(long long)(stamps[MK_PA1] - stamps[MK_PA0]) * 0.01f; float dB = (float)(long long)(stamps[MK_PB1] - stamps[MK_PB0]) * 0.01f;
            if (MK_PB0 >= 100) { long long sum = 0; for (int jj = 0; jj < 16; ++jj) sum += (long long)(stamps[32 + jj * 12 + (MK_PB1 - 100)] - stamps[32 + jj * 12 + (MK_PB0 - 100)]); dB = (float)sum * 0.01f; }
            const float cA = MK_PCAL ? 0.1f : dA * 0.00025f;
            const int gw = F.vcu * NWAVES + F.wave, NGW = F.G * NWAVES;
            for (int m = gw; m < M; m += NGW) { GAS f32x4* xr = (GAS f32x4*)(args.out + (size_t)m * D) + F.lane;
#pragma unroll
                for (int j = 0; j < 4; ++j) xr[64 * j] = xr[64 * j] + cA; }
            if (gw == 0 && F.lane == 0) { asm volatile("s_waitcnt vmcnt(0)" ::: "memory"); args.out[0] += dB * 0.1f; }
        }
#endif
    }
#undef IN
#undef BOTH
}

extern "C" void kernel_launch(void* const* d_in, const int* in_sizes, int n_in, void* d_out, int out_size, void* d_ws, size_t ws_size, hipStream_t stream) {
    static int grid = 0;
    if (grid == 0) {
        if (n_in != 28 || in_sizes[0] != M * D || out_size != M * D || ws_size < WS_END) { fprintf(stderr, "kernel_launch: unexpected shapes/workspace (n_in %d, ws %zu)\n", n_in, ws_size); grid = -1; return; }
        int dev = 0, cus = 0, per_cu = 0;
        if (hipGetDevice(&dev) != hipSuccess || hipDeviceGetAttribute(&cus, hipDeviceAttributeMultiprocessorCount, dev) != hipSuccess) { grid = -1; return; }
        if (hipFuncSetAttribute((const void*)mk_fwd, hipFuncAttributeMaxDynamicSharedMemorySize, LDS_BYTES) != hipSuccess) { fprintf(stderr, "kernel_launch: hipFuncSetAttribute failed\n"); grid = -1; return; }
        if (hipOccupancyMaxActiveBlocksPerMultiprocessor(&per_cu, (const void*)mk_fwd, NWAVES * 64, LDS_BYTES) != hipSuccess || per_cu < 1) fprintf(stderr, "kernel_launch: occupancy query reports %d\n", per_cu);
        (void)hipGetLastError();
        grid = cus;
    }
    if (grid < 0) return;
    if (hipMemsetAsync((char*)d_ws + WS_CTL, 0, CTL_ZERO_BYTES, stream) != hipSuccess) return;
    Args a{};
    for (int i = 0; i < 28; ++i) a.in[i] = (const float*)d_in[i];
    a.out = (float*)d_out; a.ws = (unsigned char*)d_ws;
#if MK_ONE_LAUNCH
    a.ph_lo = 0; a.ph_hi = NPHASE; a.li = 0;
    hipLaunchKernelGGL(mk_fwd, dim3(grid), dim3(NWAVES * 64), LDS_BYTES, stream, a);
#else
    for (int li = 0; li < NPHASE; ++li) { a.ph_lo = li; a.ph_hi = li + 1; a.li = li;
        hipLaunchKernelGGL(mk_fwd, dim3(grid), dim3(NWAVES * 64), LDS_BYTES, stream, a); }
#endif
}
```
